# Optimizing an MI355X kernel written in HIP

```python
import jax, jax.numpy as jnp
from jax import lax
import numpy as np

D_MODEL = 2048
BATCH = 1
SEQ = 8192
DEPTH = 4

HEAD_DIM = 64
RWKV_HEADS = 12
RWKV_WIDTH = RWKV_HEADS * HEAD_DIM
DECAY_LORA = 64
ICLR_LORA = 64
GATE_LORA = 128
ATTN_Q_HEADS = 12
ATTN_KV_HEADS = 4
ATTN_GROUP = ATTN_Q_HEADS // ATTN_KV_HEADS
ATTN_WIDTH = ATTN_Q_HEADS * HEAD_DIM
WINDOW = 128
GM_HEADS = 4
GM_HEAD_DIM = 128
GM_WIDTH = GM_HEADS * GM_HEAD_DIM
GM_CHUNK = 128
MIX_WIDTH = RWKV_WIDTH + ATTN_WIDTH + GM_WIDTH
D_FF = 4 * D_MODEL
RWKV_COLS = 3 * RWKV_WIDTH + DECAY_LORA + ICLR_LORA + GATE_LORA
ATTN_COLS = ATTN_WIDTH + 2 * ATTN_KV_HEADS * HEAD_DIM
GM_COLS = 2 * GM_WIDTH
IN_COLS = RWKV_COLS + ATTN_COLS + GM_COLS
NORM_EPS = 1e-6
GN_EPS = 64e-5

kernel_name = "hymba_style_rwkv7_swa_gmlp_trunk"


def _rmsnorm(x, g):
    xf = x.astype(jnp.float32)
    y = xf * lax.rsqrt(jnp.mean(xf * xf, axis=-1, keepdims=True) + NORM_EPS)
    return (y * g.astype(jnp.float32)).astype(x.dtype)


def _layernorm(x, g, b):
    xf = x.astype(jnp.float32)
    mu = jnp.mean(xf, axis=-1, keepdims=True)
    var = jnp.mean(jnp.square(xf - mu), axis=-1, keepdims=True)
    y = (xf - mu) * lax.rsqrt(var + NORM_EPS)
    return (y * g.astype(jnp.float32) + b.astype(jnp.float32)).astype(x.dtype)


def _rwkv7_scan(r, decay, k, v, kk, a):
    B, S, H, N = r.shape
    xs = tuple(jnp.moveaxis(t, 1, 0) for t in (r, decay, k, v, -kk, kk * a))

    def step(state, inp):
        r_t, w_t, k_t, v_t, a_t, b_t = inp
        sa = jnp.einsum('bhij,bhj->bhi', state, a_t)
        state = (state * w_t[:, :, None, :] + sa[..., None] * b_t[:, :, None, :]
                 + v_t[..., None] * k_t[:, :, None, :])
        y_t = jnp.einsum('bhij,bhj->bhi', state, r_t)
        return state, y_t

    state0 = jnp.zeros((B, H, N, N), jnp.float32)
    _, y = lax.scan(step, state0, xs)
    return jnp.moveaxis(y, 0, 1)


def _rwkv7_mix(p, mu, w0, decay_up, a0, a_up, g_up, k_k, k_a, r_k, lnx_g, lnx_b):
    B, S, _ = p.shape
    f32 = jnp.float32
    prev = jnp.pad(p, ((0, 0), (1, 0), (0, 0)))[:, :-1]
    p = p + (prev - p) * mu
    cuts = list(np.cumsum([RWKV_WIDTH, RWKV_WIDTH, RWKV_WIDTH, DECAY_LORA, ICLR_LORA]))
    r, k, v, xw, xa, xg = jnp.split(p, cuts, axis=-1)
    w = -jax.nn.softplus(-(w0 + jnp.tanh(xw) @ decay_up)) - 0.5
    decay = jnp.exp(-jnp.exp(w.astype(f32)))
    a = jax.nn.sigmoid(a0 + xa @ a_up)
    g = jax.nn.sigmoid(xg) @ g_up
    heads = lambda t: t.astype(f32).reshape(B, S, RWKV_HEADS, HEAD_DIM)
    kk = heads(k * k_k)
    kk = kk / jnp.maximum(jnp.sqrt(jnp.sum(kk * kk, axis=-1, keepdims=True)), 1e-12)
    k = k * (1.0 + (a - 1.0) * k_a)
    rh, kh, vh = heads(r), heads(k), heads(v)
    y = _rwkv7_scan(rh, heads(decay), kh, vh, kk, heads(a))
    m = jnp.mean(y, axis=-1, keepdims=True)
    var = jnp.mean(jnp.square(y - m), axis=-1, keepdims=True)
    y = ((y - m) * lax.rsqrt(var + GN_EPS)).reshape(B, S, RWKV_WIDTH)
    y = y * lnx_g.astype(f32) + lnx_b.astype(f32)
    bonus = jnp.sum(rh * kh * r_k.astype(f32), axis=-1, keepdims=True) * vh
    y = y + bonus.reshape(B, S, RWKV_WIDTH)
    return (y * g.astype(f32)).astype(p.dtype)


def _swa_sinks(p, sinks):
    B, S, _ = p.shape
    nb = S // WINDOW
    kvw = ATTN_KV_HEADS * HEAD_DIM
    q, k, v = jnp.split(p, [ATTN_WIDTH, ATTN_WIDTH + kvw], axis=-1)
    q = q.reshape(B, nb, WINDOW, ATTN_KV_HEADS, ATTN_GROUP, HEAD_DIM)
    k = k.reshape(B, nb, WINDOW, ATTN_KV_HEADS, HEAD_DIM)
    v = v.reshape(B, nb, WINDOW, ATTN_KV_HEADS, HEAD_DIM)

    def with_prev(t):
        prev = jnp.concatenate([jnp.zeros_like(t[:, :1]), t[:, :-1]], axis=1)
        return jnp.concatenate([prev, t], axis=2)

    kb, vb = with_prev(k), with_prev(v)
    s = jnp.einsum('bnqhgd,bnkhd->bnhgqk', q, kb).astype(jnp.float32) * (HEAD_DIM ** -0.5)
    i = jnp.arange(WINDOW)[:, None]
    j = jnp.arange(2 * WINDOW)[None, :]
    band = (j > i) & (j <= i + WINDOW)
    valid = (jnp.arange(nb)[:, None, None] > 0) | (j >= WINDOW)[None]
    mask = band[None] & valid
    s = jnp.where(mask[None, :, None, None], s, -jnp.inf)
    sink = jnp.broadcast_to(
        sinks.astype(jnp.float32).reshape(1, 1, ATTN_KV_HEADS, ATTN_GROUP, 1, 1),
        s.shape[:-1] + (1,))
    prob = jax.nn.softmax(jnp.concatenate([s, sink], axis=-1), axis=-1)[..., :-1]
    o = jnp.einsum('bnhgqk,bnkhd->bnqhgd', prob.astype(vb.dtype), vb)
    return o.reshape(B, S, ATTN_WIDTH)


def _chunk_gmlp(p, ln_g, ln_b, ws, bs):
    B, S, _ = p.shape
    nc = S // GM_CHUNK
    z = jax.nn.gelu(p, approximate=False)
    u, z2 = jnp.split(z, 2, axis=-1)
    z2 = _layernorm(z2, ln_g, ln_b).reshape(B, nc, GM_CHUNK, GM_HEADS, GM_HEAD_DIM)
    causal = jnp.tril(jnp.ones((GM_CHUNK, GM_CHUNK), dtype=bool))
    w = jnp.where(causal[None], ws, jnp.zeros_like(ws))
    mixed = jnp.einsum('hts,bcshe->bcthe', w, z2) + bs.T[:, :, None]
    u = u.reshape(B, nc, GM_CHUNK, GM_HEADS, GM_HEAD_DIM)
    return (u * mixed).reshape(B, S, GM_WIDTH)


def setup_inputs(seed: int = 0) -> dict:
    key = jax.random.key(seed)
    ks = jax.random.split(key, 32)
    L, D = DEPTH, D_MODEL
    nrm = lambda k, shape, scale: jax.random.normal(k, shape, jnp.float32) * scale
    return {
        "x": nrm(ks[0], (BATCH, SEQ, D), 1.0),
        "ln1_g": 1.0 + nrm(ks[1], (L, D), 0.02),
        "w_in": nrm(ks[2], (L, D, IN_COLS), D ** -0.5),
        "rwkv_mu": jax.random.uniform(ks[3], (L, RWKV_COLS), jnp.float32),
        "rwkv_w0": jax.random.uniform(ks[4], (L, RWKV_WIDTH), jnp.float32, -5.0, 0.5),
        "rwkv_decay_up": nrm(ks[5], (L, DECAY_LORA, RWKV_WIDTH), 0.1 * DECAY_LORA ** -0.5),
        "rwkv_a0": nrm(ks[6], (L, RWKV_WIDTH), 0.1),
        "rwkv_a_up": nrm(ks[7], (L, ICLR_LORA, RWKV_WIDTH), 0.1 * ICLR_LORA ** -0.5),
        "rwkv_g_up": nrm(ks[8], (L, GATE_LORA, RWKV_WIDTH), GATE_LORA ** -0.5),
        "rwkv_k_k": 0.85 + nrm(ks[9], (L, RWKV_WIDTH), 0.05),
        "rwkv_k_a": 1.0 + nrm(ks[10], (L, RWKV_WIDTH), 0.05),
        "rwkv_r_k": nrm(ks[11], (L, RWKV_HEADS, HEAD_DIM), 0.1),
        "rwkv_lnx_g": 1.0 + nrm(ks[12], (L, RWKV_WIDTH), 0.02),
        "rwkv_lnx_b": nrm(ks[13], (L, RWKV_WIDTH), 0.02),
        "attn_sinks": nrm(ks[14], (L, ATTN_Q_HEADS), 1.0),
        "attn_norm_g": 1.0 + nrm(ks[15], (L, ATTN_WIDTH), 0.02),
        "gm_ln_g": 1.0 + nrm(ks[16], (L, GM_WIDTH), 0.02),
        "gm_ln_b": nrm(ks[17], (L, GM_WIDTH), 0.02),
        "gm_ws": nrm(ks[18], (L, GM_HEADS, GM_CHUNK, GM_CHUNK), GM_CHUNK ** -0.5),
        "gm_bs": 1.0 + nrm(ks[19], (L, GM_HEADS, GM_CHUNK), 0.1),
        "gm_norm_g": 1.0 + nrm(ks[20], (L, GM_WIDTH), 0.02),
        "w_out": nrm(ks[21], (L, MIX_WIDTH, D), MIX_WIDTH ** -0.5),
        "ln2_g": 1.0 + nrm(ks[22], (L, D), 0.02),
        "w_ffn_up": nrm(ks[23], (L, D, D_FF), D ** -0.5),
        "w_ffn_down": nrm(ks[24], (L, D_FF, D), D_FF ** -0.5),
        "lnf_g": 1.0 + nrm(ks[25], (D,), 0.02),
    }


def reference(x, ln1_g, w_in, rwkv_mu, rwkv_w0, rwkv_decay_up, rwkv_a0, rwkv_a_up,
              rwkv_g_up, rwkv_k_k, rwkv_k_a, rwkv_r_k, rwkv_lnx_g, rwkv_lnx_b,
              attn_sinks, attn_norm_g, gm_ln_g, gm_ln_b, gm_ws, gm_bs, gm_norm_g,
              w_out, ln2_g, w_ffn_up, w_ffn_down, lnf_g):
    for l in range(DEPTH):
        h = _rmsnorm(x, ln1_g[l])
        p = h @ w_in[l]
        p_r, p_a, p_g = jnp.split(p, [RWKV_COLS, RWKV_COLS + ATTN_COLS], axis=-1)
        y_r = _rwkv7_mix(p_r, rwkv_mu[l], rwkv_w0[l], rwkv_decay_up[l], rwkv_a0[l],
                         rwkv_a_up[l], rwkv_g_up[l], rwkv_k_k[l], rwkv_k_a[l],
                         rwkv_r_k[l], rwkv_lnx_g[l], rwkv_lnx_b[l])
        y_a = _rmsnorm(_swa_sinks(p_a, attn_sinks[l]), attn_norm_g[l])
        y_g = _rmsnorm(_chunk_gmlp(p_g, gm_ln_g[l], gm_ln_b[l], gm_ws[l], gm_bs[l]), gm_norm_g[l])
        x = x + jnp.concatenate([y_r, y_a, y_g], axis=-1) @ w_out[l]
        h = _rmsnorm(x, ln2_g[l])
        x = x + jnp.square(jax.nn.relu(h @ w_ffn_up[l])) @ w_ffn_down[l]
    return _rmsnorm(x, lnf_g)
```

```cpp
#include <hip/hip_runtime.h>
#include <hip/hip_cooperative_groups.h>
#include <cstdio>
namespace cg = cooperative_groups;

#ifndef MK_COOP
#define MK_COOP 1
#endif
#ifndef MK_REP_MASK
#define MK_REP_MASK 0
#endif
#ifndef MK_ONLY
#define MK_ONLY -1
#endif
#define SEL(x) (MK_ONLY < 0 || MK_ONLY == (x))

#define LAS __attribute__((address_space(3)))
typedef unsigned short bf16_t;
typedef short bf16x8 __attribute__((ext_vector_type(8)));
typedef float f32x4 __attribute__((ext_vector_type(4)));
typedef float f32x2 __attribute__((ext_vector_type(2)));
typedef unsigned u32x4 __attribute__((ext_vector_type(4)));
typedef unsigned u32x2 __attribute__((ext_vector_type(2)));

constexpr int SEQ = 8192, DM = 2048, DEPTH = 4, INC = 4864, DFF = 8192;
constexpr int RW = 768, NH = 12;
constexpr int COL_K = 768, COL_V = 1536, COL_XW = 2304, COL_XA = 2368, COL_XG = 2432;
constexpr int COL_AQ = 2560, COL_AK = 3328, COL_AV = 3584, COL_GU = 3840, COL_GZ = 4352;
constexpr float NORM_EPS = 1e-6f, GN_EPS = 64e-5f;
constexpr int SEGLEN = 64, NSEG = SEQ / SEGLEN;
constexpr int OPB = 896, OPTB = NH * OPB;
constexpr int NTHREADS = 512;
constexpr int LDS_BYTES = 147456;

constexpr size_t SZ_WIN = (size_t)INC * DM * 2, SZ_WOUT = (size_t)DM * DM * 2, SZ_WUP = (size_t)DFF * DM * 2, SZ_WDN = (size_t)DM * DFF * 2;
constexpr size_t SZ_LORA = 524288;
constexpr size_t WS_WIN = 0;
constexpr size_t WS_WOUT = WS_WIN + DEPTH * SZ_WIN;
constexpr size_t WS_WUP = WS_WOUT + DEPTH * SZ_WOUT;
constexpr size_t WS_WDN = WS_WUP + DEPTH * SZ_WUP;
constexpr size_t WS_LORA = WS_WDN + DEPTH * SZ_WDN;
constexpr size_t WS_X = WS_LORA + DEPTH * SZ_LORA;
constexpr size_t WS_XB = WS_X + (size_t)SEQ * DM * 4;
constexpr size_t WS_SSQ = WS_XB + (size_t)SEQ * DM * 2;
constexpr size_t WS_MIX = WS_SSQ + (size_t)SEQ * 32 * 4;
constexpr size_t WS_U = WS_MIX + (size_t)SEQ * DM * 2;
constexpr size_t WS_P = WS_U;
constexpr size_t WS_OPND = WS_P + (size_t)SEQ * INC * 2;
constexpr size_t WS_GATE = WS_OPND + (size_t)SEQ * OPTB;
constexpr size_t WS_BONUS = WS_GATE + (size_t)SEQ * RW * 4;
constexpr size_t WS_YRAW = WS_BONUS + (size_t)SEQ * 16 * 4;
constexpr size_t WS_ORAW = WS_YRAW + (size_t)SEQ * RW * 4;
constexpr size_t WS_SSQA = WS_ORAW + (size_t)SEQ * RW * 4;
constexpr size_t WS_TG = WS_SSQA + (size_t)SEQ * 4 * 4;
constexpr size_t WS_LG = WS_TG + (size_t)NH * NSEG * 4096 * 4;
constexpr size_t WS_SS = WS_LG + (size_t)NH * NSEG * 4096 * 4;
constexpr size_t WS_GRAW = WS_SS + (size_t)NH * NSEG * 4096 * 4;
constexpr size_t WS_Z = WS_GRAW + (size_t)SEQ * 512 * 4;
constexpr size_t WS_BAR = WS_Z + (size_t)SEQ * RW * 4;
constexpr size_t WS_END_MIX = WS_BAR + 16384;
constexpr size_t WS_HB = WS_U;
constexpr size_t WS_END = WS_END_MIX;
static_assert(WS_HB + (size_t)SEQ * DFF * 2 <= WS_END, "ffn buffer fits the union");
static_assert(WS_END <= (size_t)1073741824, "workspace budget");

struct Params { const float* in[26]; float* out; unsigned char* ws; int ph_lo, ph_hi; };
struct Lt { int tid, bid; };

typedef __bf16 bf16x2_t __attribute__((ext_vector_type(2)));
__device__ __forceinline__ unsigned cvt_pk_bf16(float lo, float hi) { const f32x2 v = {lo, hi}; return __builtin_bit_cast(unsigned, __builtin_convertvector(v, bf16x2_t)); }
__device__ __forceinline__ float bflo(unsigned u) { return __uint_as_float(u << 16); }
__device__ __forceinline__ float bfhi(unsigned u) { return __uint_as_float(u & 0xffff0000u); }
__device__ __forceinline__ void lds_barrier() { asm volatile("s_waitcnt lgkmcnt(0)" ::: "memory"); __builtin_amdgcn_s_barrier(); asm volatile("" ::: "memory"); }
__device__ __forceinline__ float xor16(float v) { return __shfl_xor(v, 16); }
__device__ __forceinline__ float xor32(float v) { return __shfl_xor(v, 32); }
__device__ __forceinline__ float quad_sum(float v) { v += xor16(v); v += xor32(v); return v; }
__device__ __forceinline__ float row16_sum(float v) { v += __shfl_xor(v, 1); v += __shfl_xor(v, 2); v += __shfl_xor(v, 4); v += __shfl_xor(v, 8); return v; }
__device__ __forceinline__ float gelu_exact(float v) {
    const float av = fabsf(v), t = __builtin_amdgcn_rcpf(av * 0.2316418882f + 1.0f);
    float q = t * 0.5307027145f + (-0.7265760135f); q = q * t + 0.7107068705f; q = q * t + (-0.142248368f); q = q * t + 0.127414796f; q = q * t;
    const float e = __builtin_amdgcn_exp2f((v * v) * (-0.72134752044f));
    const float m = v * (q * e);
    return v < 0.f ? m : v - m;
}
__device__ __forceinline__ float sigmoidf_(float x) { return __builtin_amdgcn_rcpf(1.0f + __expf(-x)); }
__device__ __forceinline__ float tanhf_(float x) { return 1.0f - 2.0f * __builtin_amdgcn_rcpf(1.0f + __expf(2.0f * x)); }
__device__ __forceinline__ float row_rstd(const float* ssq, int row, float inv_n) {
    const f32x4* p = (const f32x4*)(ssq + (size_t)row * 32);
    f32x4 s = p[0];
#pragma unroll
    for (int i = 1; i < 8; ++i) s += p[i];
    return rsqrtf((s[0] + s[1] + s[2] + s[3]) * inv_n + NORM_EPS);
}

namespace pg8 {
constexpr int BM = 256, BK = 64, HALF = 128, HTB = HALF * BK * 2, STAGE_BYTES = 8 * HTB, NXCD = 8, WGM = 8;
__host__ __device__ __forceinline__ int lds_byte(int r, int c) { const int st = (r >> 4) * 2 + (c >> 5), rr = r & 15, cc = c & 31, ob = rr * 64 + cc * 2; return st * 1024 + (ob ^ (((ob >> 9) & 1) << 5)); }
__host__ __device__ __forceinline__ void stage_rc(int b, int& R, int& C) { const int st = b / 1024, sb = b % 1024, swz = sb ^ (((sb >> 9) & 1) << 5); R = (st >> 1) * 16 + swz / 64; C = (st & 1) * 32 + (swz % 64) / 2; }
__host__ __device__ __forceinline__ int perm32(int rho) { const int n = rho >> 4, i = rho & 15; return 8 * (i >> 2) + 4 * n + (i & 3); }
struct Unit { int pm, pn; };
struct Gemm { const bf16_t* A; const bf16_t* Bt; int M, N, K; };
struct StaticOrder {
    int nM, nN, nwg, G, c;
    __device__ void init(int M, int N, int G_, int c_) { nM = M / BM; nN = N / BM; nwg = nM * nN; G = G_; c = c_; }
    __device__ bool next(int i, Unit& u) const {
        const long L = (long)i * G + c; if (L >= nwg) return false;
        int wgid = (int)L; { const int q = nwg / NXCD, r = nwg % NXCD, xcd = wgid % NXCD, off = wgid / NXCD; wgid = (xcd < r ? xcd * (q + 1) : r * (q + 1) + (xcd - r) * q) + off; }
        const int nig = WGM * nN, gid = wgid / nig, fm = gid * WGM, gsz = (nM - fm) < WGM ? (nM - fm) : WGM;
        u.pm = fm + ((wgid % nig) % gsz); u.pn = (wgid % nig) / gsz; return true;
    }
};
template <bool ALIGN_EPI, class Epi>
__device__ __forceinline__ void gemm_phase(const Lt& lt, LAS unsigned char* lds, const Gemm g, const StaticOrder& S, const Epi& E) {
    const int tid = lt.tid, wid = __builtin_amdgcn_readfirstlane(tid >> 6), lane = tid & 63, wr = wid >> 2, wc = wid & 3, fr = lane & 15, fq = lane >> 4;
    const int K = g.K, nt = K / BK;
    unsigned voffA[2], voffB[2];
#pragma unroll
    for (int i = 0; i < 2; ++i) { int R, C; stage_rc(tid * 16 + i * 8192, R, C); const int Rb = (R & ~31) + perm32(R & 31);
        voffA[i] = (unsigned)(R * K + C) * 2u; voffB[i] = (unsigned)(Rb * K + C) * 2u; }
    const size_t kstep = (size_t)(BK * 2);
    const size_t hstep = (size_t)HALF * K * 2;
    const size_t tstep = 2 * hstep;
    const unsigned ldsw = (unsigned)wid * 1024u;
    const int aoff = lds_byte(wr * 64 + fr, fq * 8), boff = lds_byte(wc * 32 + fr, fq * 8);
#define PG8_SA(b, h) (((b) * 2 + (h)) * HTB)
#define PG8_SB(b, h) ((4 + (b) * 2 + (h)) * HTB)
#define PG8_STAGE(bufoff, gbase, voff) do { _Pragma("unroll") for (int _i = 0; _i < 2; ++_i) \
        __builtin_amdgcn_global_load_lds((const unsigned*)((const char*)(gbase) + (voff)[_i]), (LAS unsigned*)(lds + (bufoff) + ldsw + _i * 8192), 16, 0, 0); } while (0)
#define PG8_LDA(dst, b, h) do { _Pragma("unroll") for (int m = 0; m < 4; ++m) _Pragma("unroll") for (int k = 0; k < 2; ++k) dst[m][k] = *(const LAS bf16x8*)(lds + PG8_SA(b, h) + aoff + m * 2048 + k * 1024); } while (0)
#define PG8_LDB(dst, b, h) do { _Pragma("unroll") for (int n = 0; n < 2; ++n) _Pragma("unroll") for (int k = 0; k < 2; ++k) dst[n][k] = *(const LAS bf16x8*)(lds + PG8_SB(b, h) + boff + n * 2048 + k * 1024); } while (0)
#define PG8_MMA(ai, bj, At, Bt) do { __builtin_amdgcn_s_setprio(2); _Pragma("unroll") for (int m = 0; m < 4; ++m) _Pragma("unroll") for (int n = 0; n < 2; ++n) _Pragma("unroll") for (int k = 0; k < 2; ++k) \
        acc[ai][bj][m][n] = __builtin_amdgcn_mfma_f32_16x16x32_bf16(Bt[n][k], At[m][k], acc[ai][bj][m][n], 0, 0, 0); __builtin_amdgcn_s_setprio(0); } while (0)
#define PG8_WAIT_V(n) asm volatile("s_waitcnt vmcnt(" #n ")" ::: "memory")
#define PG8_WAIT_L(n) asm volatile("s_waitcnt lgkmcnt(" #n ")" ::: "memory")
#define PG8_BAR __builtin_amdgcn_s_barrier()
#define PG8_SCHED __builtin_amdgcn_sched_barrier(0)
    Unit cur, nxt; int ui = 0;
    if (!S.next(0, cur)) return;
    E.prepare(cur, lds, 0, tid);
    f32x4 acc[2][2][4][2];
#pragma unroll
    for (int a = 0; a < 2; ++a)
#pragma unroll
        for (int b = 0; b < 2; ++b)
#pragma unroll
            for (int m = 0; m < 4; ++m)
#pragma unroll
                for (int n = 0; n < 2; ++n) acc[a][b][m][n] = (f32x4){0.f, 0.f, 0.f, 0.f};
    bf16x8 At[4][2], B0[2][2], B1[2][2];
    const char* cA = (const char*)g.A + (size_t)cur.pm * tstep; const char* cB = (const char*)g.Bt + (size_t)cur.pn * tstep;
    PG8_STAGE(PG8_SB(0, 0), cB, voffB); PG8_STAGE(PG8_SB(0, 1), cB + hstep, voffB); PG8_STAGE(PG8_SA(0, 0), cA, voffA); PG8_STAGE(PG8_SA(0, 1), cA + hstep, voffA);
    if (wr == 1) PG8_BAR;
    PG8_WAIT_V(2); PG8_BAR;
    PG8_STAGE(PG8_SB(1, 0), cB + kstep, voffB); PG8_STAGE(PG8_SA(1, 0), cA + kstep, voffA); PG8_STAGE(PG8_SB(1, 1), cB + hstep + kstep, voffB);
    PG8_WAIT_V(6); PG8_BAR;
    for (;;) {
        const bool has_next = S.next(ui + 1, nxt);
        const char* nA = has_next ? (const char*)g.A + (size_t)nxt.pm * tstep : cA; const char* nB = has_next ? (const char*)g.Bt + (size_t)nxt.pn * tstep : cB;
        for (int t = 0; t < nt; t += 2) {
            const bool last = (t == nt - 2);
            const char* a1 = cA + (size_t)(t + 1) * kstep;
            const char* a2 = last ? nA : cA + (size_t)(t + 2) * kstep; const char* b2 = last ? nB : cB + (size_t)(t + 2) * kstep;
            const char* a3 = a2 + kstep; const char* b3 = b2 + kstep;
            PG8_LDB(B0, 0, 0); PG8_LDB(B1, 0, 1); PG8_SCHED; PG8_LDA(At, 0, 0); PG8_STAGE(PG8_SA(1, 1), a1 + hstep, voffA);
            PG8_WAIT_V(8); PG8_WAIT_L(0); PG8_BAR; PG8_MMA(0, 0, At, B0); PG8_MMA(0, 1, At, B1); PG8_BAR; PG8_SCHED;
            PG8_LDA(At, 0, 1); PG8_STAGE(PG8_SB(0, 0), b2, voffB); PG8_STAGE(PG8_SB(0, 1), b2 + hstep, voffB); PG8_STAGE(PG8_SA(0, 0), a2, voffA);
            PG8_WAIT_V(8); PG8_WAIT_L(0); PG8_BAR; PG8_MMA(1, 0, At, B0); PG8_MMA(1, 1, At, B1); PG8_BAR; PG8_SCHED;
            PG8_LDB(B0, 1, 0); PG8_LDB(B1, 1, 1); PG8_SCHED; PG8_LDA(At, 1, 0); PG8_STAGE(PG8_SA(0, 1), a2 + hstep, voffA);
            PG8_WAIT_V(8); PG8_WAIT_L(0); PG8_BAR; PG8_MMA(0, 0, At, B0); PG8_MMA(0, 1, At, B1); PG8_BAR; PG8_SCHED;
            PG8_LDA(At, 1, 1); PG8_STAGE(PG8_SB(1, 0), b3, voffB); PG8_STAGE(PG8_SB(1, 1), b3 + hstep, voffB); PG8_STAGE(PG8_SA(1, 0), a3, voffA);
            PG8_WAIT_V(8); PG8_WAIT_L(0); PG8_BAR; PG8_MMA(1, 0, At, B0); PG8_MMA(1, 1, At, B1); PG8_BAR; PG8_SCHED;
        }
        if (ALIGN_EPI) { if (wr == 0) PG8_BAR; }
        E(acc, cur, wr, wc, fr, fq, lds, ui & 1);
        if (!has_next) break;
        E.prepare(nxt, lds, (ui + 1) & 1, tid);
#pragma unroll
        for (int a = 0; a < 2; ++a)
#pragma unroll
            for (int b = 0; b < 2; ++b)
#pragma unroll
                for (int m = 0; m < 4; ++m)
#pragma unroll
                    for (int n = 0; n < 2; ++n) acc[a][b][m][n] = (f32x4){0.f, 0.f, 0.f, 0.f};
        cur = nxt; cA = nA; cB = nB; ++ui;
        if (ALIGN_EPI) { if (wr == 1) PG8_BAR; }
    }
    PG8_WAIT_V(0);
    if (!ALIGN_EPI) { if (wr == 0) PG8_BAR; }
    PG8_BAR;
#undef PG8_SA
#undef PG8_SB
#undef PG8_STAGE
#undef PG8_LDA
#undef PG8_LDB
#undef PG8_MMA
#undef PG8_WAIT_V
#undef PG8_WAIT_L
#undef PG8_BAR
#undef PG8_SCHED
}
}

template <int ACT> struct EpiScaleBf16 {
    bf16_t* O; int ldc; const float* ssq;
    __device__ __forceinline__ void prepare(const pg8::Unit& u, LAS unsigned char* lds, int buf, int tid) const {
        if (tid < 256) ((LAS float*)(lds + pg8::STAGE_BYTES))[buf * 256 + tid] = row_rstd(ssq, u.pm * 256 + tid, 1.0f / DM);
    }
    __device__ __forceinline__ void operator()(const f32x4 (&acc)[2][2][4][2], const pg8::Unit& u, int wr, int wc, int fr, int fq, LAS unsigned char* lds, int buf) const {
        const int row0 = u.pm * 256 + wr * 64 + fr, col0 = u.pn * 256 + wc * 32 + 8 * fq;
        const LAS float* rst = (const LAS float*)(lds + pg8::STAGE_BYTES) + buf * 256 + wr * 64 + fr;
        float rs[2][4];
#pragma unroll
        for (int ai = 0; ai < 2; ++ai)
#pragma unroll
            for (int m = 0; m < 4; ++m) rs[ai][m] = rst[ai * 128 + m * 16];
#pragma unroll
        for (int ai = 0; ai < 2; ++ai)
#pragma unroll
            for (int m = 0; m < 4; ++m) {
                const int row = row0 + ai * 128 + m * 16;
                bf16_t* rowp = O + (size_t)row * ldc + col0;
#pragma unroll
                for (int bj = 0; bj < 2; ++bj) {
                    f32x4 v0 = acc[ai][bj][m][0] * rs[ai][m], v1 = acc[ai][bj][m][1] * rs[ai][m];
                    if (ACT == 1) {
#pragma unroll
                        for (int j = 0; j < 4; ++j) { const float a = fmaxf(v0[j], 0.f), b = fmaxf(v1[j], 0.f); v0[j] = a * a; v1[j] = b * b; }
                    }
                    u32x4 w; w.x = cvt_pk_bf16(v0[0], v0[1]); w.y = cvt_pk_bf16(v0[2], v0[3]); w.z = cvt_pk_bf16(v1[0], v1[1]); w.w = cvt_pk_bf16(v1[2], v1[3]);
                    *(u32x4*)(rowp + bj * 128) = w;
                }
            }
    }
};
struct EpiRes {
    const float* xsrc; float* xdst; bf16_t* xb; float* ssq;
    __device__ __forceinline__ void prepare(const pg8::Unit&, LAS unsigned char*, int, int) const {}
    __device__ __forceinline__ void operator()(const f32x4 (&acc)[2][2][4][2], const pg8::Unit& u, int wr, int wc, int fr, int fq, LAS unsigned char*, int) const {
        const int row0 = u.pm * 256 + wr * 64 + fr, col0 = u.pn * 256 + wc * 32 + 8 * fq;
#pragma unroll
        for (int ai = 0; ai < 2; ++ai) {
            f32x4 xv[4][2][2];
#pragma unroll
            for (int m = 0; m < 4; ++m) {
                const size_t ro = (size_t)(row0 + ai * 128 + m * 16) * DM + col0;
#pragma unroll
                for (int bj = 0; bj < 2; ++bj) { xv[m][bj][0] = *(const f32x4*)(xsrc + ro + bj * 128); xv[m][bj][1] = *(const f32x4*)(xsrc + ro + bj * 128 + 4); }
            }
#pragma unroll
            for (int m = 0; m < 4; ++m) {
                const int row = row0 + ai * 128 + m * 16;
                const size_t ro = (size_t)row * DM + col0;
                float part = 0.f;
#pragma unroll
                for (int bj = 0; bj < 2; ++bj) {
                    const f32x4 v0 = xv[m][bj][0] + acc[ai][bj][m][0], v1 = xv[m][bj][1] + acc[ai][bj][m][1];
                    *(f32x4*)(xdst + ro + bj * 128) = v0; *(f32x4*)(xdst + ro + bj * 128 + 4) = v1;
                    u32x4 w; w.x = cvt_pk_bf16(v0[0], v0[1]); w.y = cvt_pk_bf16(v0[2], v0[3]); w.z = cvt_pk_bf16(v1[0], v1[1]); w.w = cvt_pk_bf16(v1[2], v1[3]);
                    *(u32x4*)(xb + ro + bj * 128) = w;
#pragma unroll
                    for (int j = 0; j < 4; ++j) part += v0[j] * v0[j] + v1[j] * v1[j];
                }
                part = quad_sum(part);
                if (fq == 0) ssq[(size_t)row * 32 + u.pn * 4 + wc] = part;
            }
        }
    }
};

__device__ __forceinline__ void transpose_job(const Lt& lt, const float* src, bf16_t* dst, const float* scale, int K, int N, int& rot, float* tile  ) {
    const int tid = lt.tid, G = gridDim.x;
    const int tk = K / 64, tn = N / 64, ntile = tk * tn;
    const int first = (int)((lt.bid + G - (rot % G)) % G);
    for (int t = first; t < ntile; t += G) {
        const int k0 = (t / tn) * 64, n0 = (t % tn) * 64;
        { const int kr = tid >> 4, nc = (tid & 15) * 4;
#pragma unroll
          for (int h = 0; h < 2; ++h) { const f32x4 v = *(const f32x4*)(src + (size_t)(k0 + kr + h * 32) * N + n0 + nc);
              float* tp = tile + (kr + h * 32) * 65 + nc; tp[0] = v[0]; tp[1] = v[1]; tp[2] = v[2]; tp[3] = v[3]; } }
        __syncthreads();
        { const int n = tid >> 3, kc = (tid & 7) * 8; float v[8];
#pragma unroll
          for (int i = 0; i < 8; ++i) v[i] = tile[(kc + i) * 65 + n];
          if (scale) {
#pragma unroll
              for (int i = 0; i < 8; ++i) v[i] *= scale[k0 + kc + i]; }
          u32x4 w; w.x = cvt_pk_bf16(v[0], v[1]); w.y = cvt_pk_bf16(v[2], v[3]); w.z = cvt_pk_bf16(v[4], v[5]); w.w = cvt_pk_bf16(v[6], v[7]);
          *(u32x4*)(dst + (size_t)(n0 + n) * K + k0 + kc) = w; }
        __syncthreads();
    }
    rot += ntile;
}

__device__ __forceinline__ void transpose_big(const Lt& lt, const float* src, bf16_t* dst, const float* scale, int K, int N, int tlo, int thi, int phase, int c, int nc, float* tile) {
    const int tid = lt.tid;
    const int tn = N / 128;
    const int first = tlo + (((c - (tlo + phase)) % nc) + nc) % nc;
    const int kr = tid >> 5, nc4 = (tid & 31) * 4;
    const int on = tid & 127, okc = (tid >> 7) * 32;
    f32x4 pre[8];
    if (first < thi) { const int k0 = (first / tn) * 128, n0 = (first % tn) * 128;
#pragma unroll
        for (int h = 0; h < 8; ++h) pre[h] = __builtin_nontemporal_load((const f32x4*)(src + (size_t)(k0 + kr + 16 * h) * N + n0 + nc4)); }
#pragma unroll 1
    for (int t = first; t < thi; t += nc) {
        const int k0 = (t / tn) * 128, n0 = (t % tn) * 128;
#pragma unroll
        for (int h = 0; h < 8; ++h) { float* tp = tile + (kr + 16 * h) * 129 + nc4; tp[0] = pre[h][0]; tp[1] = pre[h][1]; tp[2] = pre[h][2]; tp[3] = pre[h][3]; }
        lds_barrier();
        const int tnx = t + nc;
        if (tnx < thi) { const int k1 = (tnx / tn) * 128, n1 = (tnx % tn) * 128;
#pragma unroll
            for (int h = 0; h < 8; ++h) pre[h] = __builtin_nontemporal_load((const f32x4*)(src + (size_t)(k1 + kr + 16 * h) * N + n1 + nc4)); }
        bf16_t* dp = dst + (size_t)(n0 + on) * K + k0 + okc;
#pragma unroll
        for (int q = 0; q < 4; ++q) {
            float v[8];
#pragma unroll
            for (int i = 0; i < 8; ++i) v[i] = tile[(okc + q * 8 + i) * 129 + on];
            if (scale) {
                const f32x4 s0 = *(const f32x4*)(scale + k0 + okc + q * 8), s1 = *(const f32x4*)(scale + k0 + okc + q * 8 + 4);
#pragma unroll
                for (int i = 0; i < 4; ++i) { v[i] *= s0[i]; v[4 + i] *= s1[i]; }
            }
            u32x4 w; w.x = cvt_pk_bf16(v[0], v[1]); w.y = cvt_pk_bf16(v[2], v[3]); w.z = cvt_pk_bf16(v[4], v[5]); w.w = cvt_pk_bf16(v[6], v[7]);
            *(u32x4*)(dp + q * 8) = w;
        }
        lds_barrier();
    }
}
constexpr int CONV_TILES = 2912;
__device__ __forceinline__ void convert_layer(const Params& p, const Lt& lt, int l, int glo, int ghi, int c, int nc, float* tile) {
    unsigned char* ws = p.ws;
#pragma unroll 1
    for (int m = 0; m < 4; ++m) {
        const int off = m == 0 ? 0 : (m == 1 ? 608 : (m == 2 ? 864 : 1888)), n = m == 0 ? 608 : (m == 1 ? 256 : 1024);
        const int lo = (glo > off ? glo : off) - off, hi = (ghi < off + n ? ghi : off + n) - off;
        if (lo >= hi) continue;
        const float* src = m == 0 ? p.in[2] + (size_t)l * DM * INC : (m == 1 ? p.in[21] + (size_t)l * DM * DM : (m == 2 ? p.in[23] + (size_t)l * DM * DFF : p.in[24] + (size_t)l * DFF * DM));
        bf16_t* dst = (bf16_t*)(m == 0 ? ws + WS_WIN + l * SZ_WIN : (m == 1 ? ws + WS_WOUT + l * SZ_WOUT : (m == 2 ? ws + WS_WUP + l * SZ_WUP : ws + WS_WDN + l * SZ_WDN)));
        const float* scale = m == 0 ? p.in[1] + l * DM : (m == 2 ? p.in[22] + l * DM : nullptr);
        const int K = m == 3 ? DFF : DM, N = m == 0 ? INC : (m == 2 ? DFF : DM);
        transpose_big(lt, src, dst, scale, K, N, lo, hi, off - glo, c, nc, tile);
    }
}

__device__ __forceinline__ void phase_prep(const Params& p, const Lt& lt, unsigned char* lds) {
    float* tile = (float*)lds;
    unsigned char* ws = p.ws;
    int rot = 0;
    if (gridDim.x == 256) convert_layer(p, lt, 0, 0, 864, lt.bid, gridDim.x, tile);
    else for (int l = 0; l < DEPTH; ++l) convert_layer(p, lt, l, 0, CONV_TILES, lt.bid, gridDim.x, tile);
    for (int l = 0; l < DEPTH; ++l) {
        bf16_t* lora = (bf16_t*)(ws + WS_LORA + l * SZ_LORA);
        transpose_job(lt, p.in[5] + (size_t)l * 64 * RW, lora, nullptr, 64, RW, rot, tile);
        transpose_job(lt, p.in[7] + (size_t)l * 64 * RW, lora + 49152, nullptr, 64, RW, rot, tile);
        transpose_job(lt, p.in[8] + (size_t)l * 128 * RW, lora + 98304, nullptr, 128, RW, rot, tile);
    }
    const int gtid = lt.bid * NTHREADS + lt.tid, gsz = gridDim.x * NTHREADS;
    for (int i = gtid; i < DEPTH * 4 * 128 * 128 / 2; i += gsz) {
        const int e = i * 2, l = e >> 16, r = e & 65535, t = (r >> 7) & 127, s = r & 127;
        const float a = p.in[18][e], b = p.in[18][e + 1];
        bf16_t* dst = (bf16_t*)(ws + WS_LORA + l * SZ_LORA) + 196608;
        *(unsigned*)(dst + r) = cvt_pk_bf16(s <= t ? a : 0.f, (s + 1) <= t ? b : 0.f);
    }
    const int wave = gtid >> 6, nwave = gsz >> 6, lane = lt.tid & 63;
    const float* x = p.in[0]; bf16_t* xb = (bf16_t*)(ws + WS_XB); float* ssq = (float*)(ws + WS_SSQ);
    for (int row = wave; row < SEQ; row += nwave) {
        float s = 0.f;
#pragma unroll
        for (int i = 0; i < 4; ++i) {
            const size_t o = (size_t)row * DM + i * 512 + lane * 8;
            const f32x4 a = *(const f32x4*)(x + o), b = *(const f32x4*)(x + o + 4);
            u32x4 w; w.x = cvt_pk_bf16(a[0], a[1]); w.y = cvt_pk_bf16(a[2], a[3]); w.z = cvt_pk_bf16(b[0], b[1]); w.w = cvt_pk_bf16(b[2], b[3]);
            *(u32x4*)(xb + o) = w;
#pragma unroll
            for (int j = 0; j < 4; ++j) s += a[j] * a[j] + b[j] * b[j];
        }
#pragma unroll
        for (int o = 32; o > 0; o >>= 1) s += __shfl_xor(s, o);
        if (lane < 32) ssq[(size_t)row * 32 + lane] = (lane == 0) ? s : 0.f;
    }
}

__device__ __forceinline__ void attn_item(const Params& p, const Lt& lt, int l, int item, unsigned char* lds) {
    const int tid = lt.tid, lane = tid & 63, w = __builtin_amdgcn_readfirstlane(tid >> 6), qi = lane & 15, quad = lane >> 4;
    const int nb = item >> 2, kvh = item & 3;
    const bf16_t* P = (const bf16_t*)(p.ws + WS_P);
    bf16_t* Kl = (bf16_t*)lds;
    bf16_t* VT = (bf16_t*)(lds + 36864);
    for (int u = tid; u < 2048; u += NTHREADS) {
        const int row = u >> 3, part = u & 7, tok = (nb - 1) * 128 + row;
        u32x4 kv = {0u, 0u, 0u, 0u}, vv = {0u, 0u, 0u, 0u};
        if (tok >= 0) { kv = *(const u32x4*)(P + (size_t)tok * INC + COL_AK + kvh * 64 + part * 8); vv = *(const u32x4*)(P + (size_t)tok * INC + COL_AV + kvh * 64 + part * 8); }
        *(u32x4*)(Kl + row * 72 + part * 8) = kv;
#pragma unroll
        for (int i = 0; i < 4; ++i) { VT[(part * 8 + 2 * i) * 264 + row] = (bf16_t)(vv[i] & 0xffffu); VT[(part * 8 + 2 * i + 1) * 264 + row] = (bf16_t)(vv[i] >> 16); }
    }
    __syncthreads();
    const int tok = nb * 128 + w * 16 + qi;
    float* oraw = (float*)(p.ws + WS_ORAW);
    float ssq = 0.f;
    for (int hq = 0; hq < 3; ++hq) {
        const int head = kvh * 3 + hq;
        const float sink = p.in[14][l * 12 + head];
        bf16x8 qf[2];
#pragma unroll
        for (int ks = 0; ks < 2; ++ks) qf[ks] = *(const bf16x8*)(P + (size_t)tok * INC + COL_AQ + head * 64 + ks * 32 + quad * 8);
        f32x4 sacc[9];
        float mx = sink;
#pragma unroll
        for (int rt = 0; rt < 9; ++rt) {
            const int key = (w + rt) * 16 + qi;
            f32x4 a = {0.f, 0.f, 0.f, 0.f};
#pragma unroll
            for (int ks = 0; ks < 2; ++ks) { const bf16x8 kf = *(const bf16x8*)(Kl + key * 72 + ks * 32 + quad * 8); a = __builtin_amdgcn_mfma_f32_16x16x32_bf16(kf, qf[ks], a, 0, 0, 0); }
#pragma unroll
            for (int j = 0; j < 4; ++j) {
                const int jk = (w + rt) * 16 + quad * 4 + j, i = w * 16 + qi;
                const bool valid = (jk > i) && (jk <= i + 128) && (nb > 0 || jk >= 128);
                const float s = valid ? a[j] * 0.125f : -1e30f;
                a[j] = s; mx = fmaxf(mx, s);
            }
            sacc[rt] = a;
        }
        mx = fmaxf(mx, xor16(mx)); mx = fmaxf(mx, xor32(mx));
        float lsum = 0.f;
#pragma unroll
        for (int rt = 0; rt < 9; ++rt)
#pragma unroll
            for (int j = 0; j < 4; ++j) { const float e = __expf(sacc[rt][j] - mx); sacc[rt][j] = e; lsum += e; }
        lsum = quad_sum(lsum) + __expf(sink - mx);
        f32x4 oacc[4];
#pragma unroll
        for (int dt = 0; dt < 4; ++dt) oacc[dt] = (f32x4){0.f, 0.f, 0.f, 0.f};
#pragma unroll
        for (int kb = 0; kb < 5; ++kb) {
            u32x4 pw; pw.x = cvt_pk_bf16(sacc[2 * kb][0], sacc[2 * kb][1]); pw.y = cvt_pk_bf16(sacc[2 * kb][2], sacc[2 * kb][3]);
            if (kb < 4) { pw.z = cvt_pk_bf16(sacc[(2 * kb + 1) % 9][0], sacc[(2 * kb + 1) % 9][1]); pw.w = cvt_pk_bf16(sacc[(2 * kb + 1) % 9][2], sacc[(2 * kb + 1) % 9][3]); } else { pw.z = 0u; pw.w = 0u; }
            const bf16x8 pf = __builtin_bit_cast(bf16x8, pw);
            const int key0 = (w + 2 * kb) * 16 + quad * 4, key1 = key0 + 16;
#pragma unroll
            for (int dt = 0; dt < 4; ++dt) {
                const int d = dt * 16 + qi;
                const u32x2 v0 = *(const u32x2*)(VT + d * 264 + key0);
                u32x2 v1 = {0u, 0u};
                if (kb < 4) v1 = *(const u32x2*)(VT + d * 264 + key1);
                const u32x4 vw = {v0.x, v0.y, v1.x, v1.y};
                oacc[dt] = __builtin_amdgcn_mfma_f32_16x16x32_bf16(__builtin_bit_cast(bf16x8, vw), pf, oacc[dt], 0, 0, 0);
            }
        }
        const float inv = 1.0f / lsum;
#pragma unroll
        for (int dt = 0; dt < 4; ++dt) {
            const f32x4 o = oacc[dt] * inv;
            *(f32x4*)(oraw + (size_t)tok * RW + head * 64 + dt * 16 + quad * 4) = o;
            ssq += o[0] * o[0] + o[1] * o[1] + o[2] * o[2] + o[3] * o[3];
        }
    }
    ssq = quad_sum(ssq);
    if (quad == 0) ((float*)(p.ws + WS_SSQA))[(size_t)tok * 4 + kvh] = ssq;
    __syncthreads();
}

__device__ __forceinline__ void st_bf4(unsigned char* q, f32x4 v) { u32x2 w; w.x = cvt_pk_bf16(v[0], v[1]); w.y = cvt_pk_bf16(v[2], v[3]); *(u32x2*)q = w; }
__device__ __forceinline__ f32x4 ld_bf4(const bf16_t* q) { const u32x2 u = *(const u32x2*)q; return (f32x4){bflo(u.x), bfhi(u.x), bflo(u.y), bfhi(u.y)}; }
__device__ __forceinline__ void rwkv_prep_item(const Params& p, const Lt& lt, int l, int item) {
    const int tid = lt.tid, lane = tid & 63, w = __builtin_amdgcn_readfirstlane(tid >> 6), qi = lane & 15, quad = lane >> 4;
    const int t = item * 32 + (w >> 2) * 16 + qi, hg = w & 3;
    const bf16_t* P = (const bf16_t*)(p.ws + WS_P);
    const bf16_t* pt = P + (size_t)t * INC;
    const bf16_t* pp = P + (size_t)(t > 0 ? t - 1 : 0) * INC;
    const float pm = t > 0 ? 1.f : 0.f;
    const float* mu = p.in[3] + l * 2560;
    const bf16_t* lora = (const bf16_t*)(p.ws + WS_LORA + l * SZ_LORA);
    const bf16_t* decT = lora; const bf16_t* aT = lora + 49152; const bf16_t* gT = lora + 98304;
    bf16x8 fw[2], fa[2], fg[4];
#pragma unroll
    for (int ks = 0; ks < 8; ++ks) {
        const int col = COL_XW + ks * 32 + quad * 8;
        const u32x4 c4 = *(const u32x4*)(pt + col), q4 = *(const u32x4*)(pp + col);
        const f32x4 m0 = *(const f32x4*)(mu + col), m1 = *(const f32x4*)(mu + col + 4);
        float v[8];
#pragma unroll
        for (int i = 0; i < 4; ++i) {
            const float c0 = bflo(c4[i]), c1 = bfhi(c4[i]), p0 = bflo(q4[i]) * pm, p1 = bfhi(q4[i]) * pm;
            const float mu0 = (i < 2) ? m0[2 * i] : m1[2 * i - 4], mu1 = (i < 2) ? m0[2 * i + 1] : m1[2 * i - 3];
            v[2 * i] = c0 + (p0 - c0) * mu0; v[2 * i + 1] = c1 + (p1 - c1) * mu1;
        }
        if (ks < 2) {
#pragma unroll
            for (int i = 0; i < 8; ++i) v[i] = tanhf_(v[i]);
        } else if (ks >= 4) {
#pragma unroll
            for (int i = 0; i < 8; ++i) v[i] = sigmoidf_(v[i]);
        }
        u32x4 pk; pk.x = cvt_pk_bf16(v[0], v[1]); pk.y = cvt_pk_bf16(v[2], v[3]); pk.z = cvt_pk_bf16(v[4], v[5]); pk.w = cvt_pk_bf16(v[6], v[7]);
        const bf16x8 f = __builtin_bit_cast(bf16x8, pk);
        if (ks < 2) fw[ks] = f; else if (ks < 4) fa[ks - 2] = f; else fg[ks - 4] = f;
    }
    unsigned char* opnd = p.ws + WS_OPND; float* gate = (float*)(p.ws + WS_GATE); float* bonus = (float*)(p.ws + WS_BONUS);
    const float* w0 = p.in[4] + l * RW; const float* a0 = p.in[6] + l * RW; const float* kkp = p.in[9] + l * RW; const float* kap = p.in[10] + l * RW; const float* rkp = p.in[11] + l * RW;
#pragma unroll
    for (int hh = 0; hh < 3; ++hh) {
        const int h = hg * 3 + hh;
        f32x4 va[4], vkk[4];
        float nrm = 0.f, bon = 0.f;
        unsigned char* ob = opnd + (size_t)t * OPTB + h * OPB;
#pragma unroll
        for (int ct = 0; ct < 4; ++ct) {
            const int crow = h * 64 + ct * 16 + qi;
            f32x4 aw = {0.f, 0.f, 0.f, 0.f}, aa = aw, ag = aw;
#pragma unroll
            for (int ks = 0; ks < 2; ++ks) {
                aw = __builtin_amdgcn_mfma_f32_16x16x32_bf16(*(const bf16x8*)(decT + crow * 64 + ks * 32 + quad * 8), fw[ks], aw, 0, 0, 0);
                aa = __builtin_amdgcn_mfma_f32_16x16x32_bf16(*(const bf16x8*)(aT + crow * 64 + ks * 32 + quad * 8), fa[ks], aa, 0, 0, 0);
            }
#pragma unroll
            for (int ks = 0; ks < 4; ++ks) ag = __builtin_amdgcn_mfma_f32_16x16x32_bf16(*(const bf16x8*)(gT + crow * 128 + ks * 32 + quad * 8), fg[ks], ag, 0, 0, 0);
            const int c = h * 64 + ct * 16 + quad * 4;
            const f32x4 mr = *(const f32x4*)(mu + c), mk = *(const f32x4*)(mu + COL_K + c), mv = *(const f32x4*)(mu + COL_V + c);
            const f32x4 cr = ld_bf4(pt + c), ck = ld_bf4(pt + COL_K + c), cv = ld_bf4(pt + COL_V + c);
            const f32x4 qr = ld_bf4(pp + c) * pm, qk = ld_bf4(pp + COL_K + c) * pm, qv = ld_bf4(pp + COL_V + c) * pm;
            const f32x4 r = cr + (qr - cr) * mr, k = ck + (qk - ck) * mk, v = cv + (qv - cv) * mv;
            const f32x4 w0v = *(const f32x4*)(w0 + c), a0v = *(const f32x4*)(a0 + c), kkv = *(const f32x4*)(kkp + c), kav = *(const f32x4*)(kap + c), rkv = *(const f32x4*)(rkp + c);
            f32x4 dec, a, kk, k2;
#pragma unroll
            for (int j = 0; j < 4; ++j) {
                const float z = -(w0v[j] + aw[j]);
                const float sp = fmaxf(z, 0.f) + __logf(1.0f + __expf(-fabsf(z)));
                dec[j] = __expf(-__expf(-sp - 0.5f));
                a[j] = sigmoidf_(a0v[j] + aa[j]);
                kk[j] = k[j] * kkv[j];
                nrm += kk[j] * kk[j];
                k2[j] = k[j] * (1.0f + (a[j] - 1.0f) * kav[j]);
                bon += r[j] * k2[j] * rkv[j];
            }
            va[ct] = a; vkk[ct] = kk;
            { const int cc = ct * 16 + quad * 4; *(f32x4*)(ob + cc * 4) = dec; st_bf4(ob + 512 + cc * 2, k2); st_bf4(ob + 640 + cc * 2, v); st_bf4(ob + 768 + cc * 2, r); }
            st_bf4((unsigned char*)((bf16_t*)gate + (size_t)t * RW + c), ag);
        }
        nrm = quad_sum(nrm); bon = quad_sum(bon);
        const float inv = rsqrtf(fmaxf(nrm, 1e-24f));
#pragma unroll
        for (int ct = 0; ct < 4; ++ct) {
            const int cc = ct * 16 + quad * 4;
            const f32x4 kkn = vkk[ct] * inv;
            st_bf4(ob + 256 + cc * 2, -kkn);
            st_bf4(ob + 384 + cc * 2, kkn * va[ct]);
        }
        if (quad == 0) bonus[(size_t)t * 16 + h] = bon;
    }
}

__device__ __forceinline__ void gmlp_item(const Params& p, const Lt& lt, int l, int item, unsigned char* lds) {
    const int tid = lt.tid, lane = tid & 63, w = __builtin_amdgcn_readfirstlane(tid >> 6), qi = lane & 15, quad = lane >> 4;
    const bf16_t* P = (const bf16_t*)(p.ws + WS_P);
    bf16_t* ZT = (bf16_t*)lds;
    const int t = item * 128 + w * 16 + qi;
    const bf16_t* pt = P + (size_t)t * INC;
    const float* lng = p.in[16] + l * 512; const float* lnb = p.in[17] + l * 512;
    {
        const bf16_t* src = pt + COL_GZ + quad * 128;
        float s1 = 0.f, s2 = 0.f;
#pragma unroll 4
        for (int e = 0; e < 128; e += 8) {
            const u32x4 u = *(const u32x4*)(src + e);
#pragma unroll
            for (int i = 0; i < 4; ++i) { const float g0 = gelu_exact(bflo(u[i])), g1 = gelu_exact(bfhi(u[i])); s1 += g0 + g1; s2 += g0 * g0 + g1 * g1; }
        }
        s1 = quad_sum(s1); s2 = quad_sum(s2);
        const float mean = s1 * (1.0f / 512), var = fmaxf(s2 * (1.0f / 512) - mean * mean, 0.f), rstd = rsqrtf(var + NORM_EPS);
        const int s = w * 16 + qi;
#pragma unroll 4
        for (int e = 0; e < 128; e += 8) {
            const u32x4 u = *(const u32x4*)(src + e);
#pragma unroll
            for (int i = 0; i < 4; ++i) {
                const int c = quad * 128 + e + 2 * i;
                const float z0 = (gelu_exact(bflo(u[i])) - mean) * rstd * lng[c] + lnb[c], z1 = (gelu_exact(bfhi(u[i])) - mean) * rstd * lng[c + 1] + lnb[c + 1];
                const unsigned pk = cvt_pk_bf16(z0, z1);
                ZT[c * 136 + s] = (bf16_t)(pk & 0xffffu); ZT[(c + 1) * 136 + s] = (bf16_t)(pk >> 16);
            }
        }
    }
    __syncthreads();
    const bf16_t* wsb = (const bf16_t*)(p.ws + WS_LORA + l * SZ_LORA) + 196608;
    const float* bs = p.in[19] + l * 512;
    const int tl = w * 16 + qi, nks = (w >> 1) + 1;
    float ssq = 0.f;
    float* graw = (float*)(p.ws + WS_GRAW) + (size_t)t * 512;
#pragma unroll 1
    for (int h = 0; h < 4; ++h) {
        f32x4 outv[8];
#pragma unroll
        for (int et = 0; et < 8; ++et) outv[et] = (f32x4){0.f, 0.f, 0.f, 0.f};
#pragma unroll 1
        for (int ks = 0; ks < nks; ++ks) {
            const bf16x8 bf = *(const bf16x8*)(wsb + (size_t)(h * 128 + tl) * 128 + ks * 32 + quad * 8);
#pragma unroll
            for (int et = 0; et < 8; ++et) {
                const bf16x8 af = *(const bf16x8*)(ZT + (h * 128 + et * 16 + qi) * 136 + ks * 32 + quad * 8);
                outv[et] = __builtin_amdgcn_mfma_f32_16x16x32_bf16(af, bf, outv[et], 0, 0, 0);
            }
        }
        const float bsv = bs[h * 128 + tl];
#pragma unroll
        for (int et = 0; et < 8; ++et) {
            const f32x4 uu = ld_bf4(pt + COL_GU + h * 128 + et * 16 + quad * 4);
            f32x4 o;
#pragma unroll
            for (int j = 0; j < 4; ++j) { o[j] = gelu_exact(uu[j]) * (outv[et][j] + bsv); ssq += o[j] * o[j]; }
            *(f32x4*)(graw + h * 128 + et * 16 + quad * 4) = o;
        }
    }
    ssq = quad_sum(ssq);
    const float rs = rsqrtf(ssq * (1.0f / 512) + NORM_EPS);
    const float* gng = p.in[20] + l * 512;
    bf16_t* mix = (bf16_t*)(p.ws + WS_MIX) + (size_t)t * DM + 1536;
#pragma unroll 4
    for (int i = 0; i < 32; ++i) {
        const int c = i * 16 + quad * 4;
        const f32x4 g4 = *(const f32x4*)(gng + c);
        const f32x4 o = *(const f32x4*)(graw + c) * rs * g4;
        u32x2 pk; pk.x = cvt_pk_bf16(o[0], o[1]); pk.y = cvt_pk_bf16(o[2], o[3]);
        *(u32x2*)(mix + c) = pk;
    }
    __syncthreads();
}

constexpr int CHMAX = 8;
template <int CTRL> __device__ __forceinline__ float dpp_mov(float v) { return __int_as_float(__builtin_amdgcn_update_dpp(0, __float_as_int(v), CTRL, 0xF, 0xF, true)); }
__device__ __forceinline__ float quad_allsum(float v) { v += dpp_mov<0xB1>(v); v += dpp_mov<0x4E>(v); return v; }
template <int NV, bool WITH_Y, int CH>
__device__ __forceinline__ void scan_run(f32x2 (&S)[4][8], const unsigned char* oh  , LAS float* wl, float* yout  , int lane) {
    const int Lc = lane < 56 ? lane : 55, cch = Lc - 16;
    const bool isw = lane < 16, act = lane < 56;
    const unsigned char* g0 = oh + Lc * 16;
    LAS float* l0 = wl + (isw ? 64 + lane * 4 : ((cch >> 3) == 0 ? 0 : 64 + (cch >> 3) * 64) + (cch & 7) * 8);
    const int cs16 = (lane & 3) * 16, rg4 = (lane >> 2) * 4;
    u32x4 pa[CH];
#pragma unroll
    for (int st = 0; st < CH; ++st) pa[st] = *(const u32x4*)(g0 + (size_t)st * OPTB);
#pragma unroll 1
    for (int c = 0; c < SEGLEN / CH; ++c) {
#pragma unroll
        for (int st = 0; st < CH; ++st) {
            const u32x4 u = pa[st];
            const f32x4 lo = isw ? __builtin_bit_cast(f32x4, u) : (f32x4){bflo(u.x), bfhi(u.x), bflo(u.y), bfhi(u.y)};
            if (act) *(LAS f32x4*)(l0 + st * 384) = lo;
            if (act && !isw) *(LAS f32x4*)(l0 + st * 384 + 4) = (f32x4){bflo(u.z), bfhi(u.z), bflo(u.w), bfhi(u.w)};
        }
        asm volatile("s_waitcnt lgkmcnt(0)" ::: "memory");
        if (c + 1 < SEGLEN / CH) {
            const unsigned char* n0 = g0 + (size_t)(c + 1) * CH * OPTB;
#pragma unroll
            for (int st = 0; st < CH; ++st) pa[st] = *(const u32x4*)(n0 + (size_t)st * OPTB);
        }
#pragma unroll 1
        for (int s = 0; s < CH; ++s) {
            const LAS float* sp = wl + s * 384 + cs16;
            f32x4 a4[4], w4[4], b4[4], k4[4], r4[4], v4 = {0.f, 0.f, 0.f, 0.f};
#pragma unroll
            for (int q = 0; q < 4; ++q) a4[q] = *(const LAS f32x4*)(sp + q * 4);
#pragma unroll
            for (int q = 0; q < 4; ++q) { w4[q] = *(const LAS f32x4*)(sp + 64 + q * 4); b4[q] = *(const LAS f32x4*)(sp + 128 + q * 4); }
            if (NV >= 5) {
#pragma unroll
                for (int q = 0; q < 4; ++q) k4[q] = *(const LAS f32x4*)(sp + 192 + q * 4);
                v4 = *(const LAS f32x4*)(wl + s * 384 + 256 + rg4);
            }
            if (WITH_Y) {
#pragma unroll
                for (int q = 0; q < 4; ++q) r4[q] = *(const LAS f32x4*)(sp + 320 + q * 4);
            }
            __builtin_amdgcn_sched_barrier(0);
            float sa[4];
#pragma unroll
            for (int r = 0; r < 4; ++r) {
                f32x2 e0 = S[r][0] * (f32x2){a4[0][0], a4[0][1]}, e1 = S[r][1] * (f32x2){a4[0][2], a4[0][3]};
#pragma unroll
                for (int q = 1; q < 4; ++q) { e0 += S[r][2 * q] * (f32x2){a4[q][0], a4[q][1]}; e1 += S[r][2 * q + 1] * (f32x2){a4[q][2], a4[q][3]}; }
                sa[r] = quad_allsum((e0[0] + e0[1]) + (e1[0] + e1[1]));
            }
#pragma unroll
            for (int q = 0; q < 4; ++q) {
                const f32x2 wlo = {w4[q][0], w4[q][1]}, whi = {w4[q][2], w4[q][3]}, blo = {b4[q][0], b4[q][1]}, bhi = {b4[q][2], b4[q][3]};
                if (NV >= 5) {
                    const f32x2 klo = {k4[q][0], k4[q][1]}, khi = {k4[q][2], k4[q][3]};
#pragma unroll
                    for (int r = 0; r < 4; ++r) {
                        const f32x2 sa2 = {sa[r], sa[r]}, vi2 = {v4[r], v4[r]};
                        S[r][2 * q] = S[r][2 * q] * wlo + (blo * sa2 + klo * vi2);
                        S[r][2 * q + 1] = S[r][2 * q + 1] * whi + (bhi * sa2 + khi * vi2);
                    }
                } else {
#pragma unroll
                    for (int r = 0; r < 4; ++r) {
                        const f32x2 sa2 = {sa[r], sa[r]};
                        S[r][2 * q] = S[r][2 * q] * wlo + blo * sa2;
                        S[r][2 * q + 1] = S[r][2 * q + 1] * whi + bhi * sa2;
                    }
                }
            }
            if (WITH_Y) {
                float y[4];
#pragma unroll
                for (int r = 0; r < 4; ++r) {
                    f32x2 e0 = S[r][0] * (f32x2){r4[0][0], r4[0][1]}, e1 = S[r][1] * (f32x2){r4[0][2], r4[0][3]};
#pragma unroll
                    for (int q = 1; q < 4; ++q) { e0 += S[r][2 * q] * (f32x2){r4[q][0], r4[q][1]}; e1 += S[r][2 * q + 1] * (f32x2){r4[q][2], r4[q][3]}; }
                    y[r] = quad_allsum((e0[0] + e0[1]) + (e1[0] + e1[1]));
                }
                const int cs = lane & 3;
                const float ysel = cs == 0 ? y[0] : (cs == 1 ? y[1] : (cs == 2 ? y[2] : y[3]));
                yout[(size_t)(c * CH + s) * RW + lane] = ysel;
            }
        }
        asm volatile("s_waitcnt lgkmcnt(0)" ::: "memory");
    }
}

__device__ __forceinline__ void phase_scan1(const Params& p, const Lt& lt, unsigned char* lds) {
    const int tid = lt.tid, w = __builtin_amdgcn_readfirstlane(tid >> 6), G = gridDim.x;
    LAS float* wl = (LAS float*)((LAS unsigned char*)lds) + w * (CHMAX * 384);
    const unsigned char* opnd = p.ws + WS_OPND;
    float* TG = (float*)(p.ws + WS_TG); float* LG = (float*)(p.ws + WS_LG);
    const int nslot = (2 * NH * NSEG + G - 1) / G;
#pragma unroll 1
    for (int j = w; j < nslot; j += 8) {
        int lane = tid & 63; asm volatile("" : "+v"(lane));
        const int kind = (j ^ (j >> 3)) & 1;
        const int rank = j >> 1;
        const int pair = rank * G + lt.bid;
        if (pair >= NH * NSEG) continue;
        const int h = pair / NSEG, g = pair % NSEG, row0 = (lane >> 2) * 4, col0 = (lane & 3) * 16;
        f32x2 S[4][8];
        const unsigned char* oh = opnd + (size_t)g * SEGLEN * OPTB + h * OPB;
        float* dst = (kind == 0 ? TG : LG) + (size_t)(h * NSEG + g) * 4096 + row0 * 64 + col0;
        if (kind == 0) {
#pragma unroll
            for (int r = 0; r < 4; ++r)
#pragma unroll
                for (int q = 0; q < 8; ++q) S[r][q] = (f32x2){(row0 + r == col0 + 2 * q) ? 1.f : 0.f, (row0 + r == col0 + 2 * q + 1) ? 1.f : 0.f};
            scan_run<3, true, 8>(S, oh, wl, (float*)(p.ws + WS_Z) + (size_t)g * SEGLEN * RW + h * 64, lane);
        } else {
#pragma unroll
            for (int r = 0; r < 4; ++r)
#pragma unroll
                for (int q = 0; q < 8; ++q) S[r][q] = (f32x2){0.f, 0.f};
            scan_run<5, true, 8>(S, oh, wl, (float*)(p.ws + WS_YRAW) + (size_t)g * SEGLEN * RW + h * 64, lane);
        }
#pragma unroll
        for (int r = 0; r < 4; ++r)
#pragma unroll
            for (int q = 0; q < 4; ++q) *(f32x4*)(dst + r * 64 + q * 4) = (f32x4){S[r][2 * q][0], S[r][2 * q][1], S[r][2 * q + 1][0], S[r][2 * q + 1][1]};
    }
}
__device__ __forceinline__ void phase_scan2(const Params& p, const Lt& lt, int nblk, unsigned char* lds) {
    const int tid = lt.tid, lane = tid & 63, w = __builtin_amdgcn_readfirstlane(tid >> 6);
    const float* TG = (const float*)(p.ws + WS_TG); const float* LG = (const float*)(p.ws + WS_LG); float* SS = (float*)(p.ws + WS_SS);
    constexpr int D = 6, SLOTF = 4096 + 1024, SP = 66;
    LAS unsigned char* ldsb = (LAS unsigned char*)lds;
    float* Rg = (float*)lds;
    float* Sx = Rg + D * SLOTF;
    const int fi = lane & 15, fq = lane >> 4;
#define CH_WAIT(n) asm volatile("s_waitcnt vmcnt(" #n ")" ::: "memory")
#pragma unroll 1
    for (int it = lt.bid; it < NH * 4; it += nblk) {
        const int h = it >> 2, i0 = (it & 3) * 16;
        const float* Th = TG + (size_t)h * NSEG * 4096 + (size_t)(2 * w) * 256 + lane * 4;
        const float* Lh = LG + (size_t)h * NSEG * 4096 + (size_t)(i0 + 4 * (w & 3)) * 64 + lane * 4;
        float* So = SS + (size_t)h * NSEG * 4096 + (size_t)(i0 + 4 * fq) * 64 + 16 * (w & 3) + fi;
#define CH_DMA(seg, slot) do { const int _sg = (seg) < NSEG - 1 ? (seg) : NSEG - 2; const unsigned _so = (unsigned)(slot) * (SLOTF * 4); \
            __builtin_amdgcn_global_load_lds((const unsigned*)(Th + (size_t)_sg * 4096), (LAS unsigned*)(ldsb + _so + (2 * w) * 1024), 16, 0, 0); \
            __builtin_amdgcn_global_load_lds((const unsigned*)(Th + (size_t)_sg * 4096 + 256), (LAS unsigned*)(ldsb + _so + (2 * w + 1) * 1024), 16, 0, 0); \
            if (w < 4) __builtin_amdgcn_global_load_lds((const unsigned*)(Lh + (size_t)_sg * 4096), (LAS unsigned*)(ldsb + _so + 16384 + w * 1024), 16, 0, 0); } while (0)
        __syncthreads();
        for (int i = tid; i < 2 * 16 * SP; i += NTHREADS) Sx[i] = 0.f;
#pragma unroll
        for (int sgm = 0; sgm < D - 1; ++sgm) CH_DMA(sgm, sgm);
        CH_WAIT(0);
        lds_barrier();
        f32x4 s4 = {0.f, 0.f, 0.f, 0.f};
        int slot = 0;
#pragma unroll 1
        for (int g = 0; g < NSEG; ++g) {
            if (w < 4) CH_WAIT(28); else CH_WAIT(8);
            lds_barrier();
            { const int fs = slot == 0 ? D - 1 : slot - 1; CH_DMA(g + D - 1, fs); }
            if (w < 4) {
#pragma unroll
                for (int r = 0; r < 4; ++r) So[(size_t)g * 4096 + r * 64] = s4[r];
                const float* As = Sx + (g & 1) * 16 * SP + fi * SP + fq;
                const float* Bs = Rg + slot * SLOTF + fq * 64 + 16 * w + fi;
                const float* Lr = Rg + slot * SLOTF + 4096 + (4 * fq) * 64 + 16 * w + fi;
                float av[16], bv[16];
#pragma unroll
                for (int ks = 0; ks < 16; ++ks) { av[ks] = As[4 * ks]; bv[ks] = Bs[(4 * ks) * 64]; }
                f32x4 c0 = {Lr[0], Lr[64], Lr[128], Lr[192]}, c1 = {0.f, 0.f, 0.f, 0.f};
                asm volatile("s_waitcnt lgkmcnt(0)" ::: "memory");
#pragma unroll
                for (int ks = 0; ks < 16; ks += 2) {
                    c0 = __builtin_amdgcn_mfma_f32_16x16x4f32(av[ks], bv[ks], c0, 0, 0, 0);
                    c1 = __builtin_amdgcn_mfma_f32_16x16x4f32(av[ks + 1], bv[ks + 1], c1, 0, 0, 0);
                }
                s4 = c0 + c1;
                float* Sn = Sx + ((g + 1) & 1) * 16 * SP + (4 * fq) * SP + 16 * w + fi;
#pragma unroll
                for (int r = 0; r < 4; ++r) Sn[r * SP] = s4[r];
            }
            slot = slot == D - 1 ? 0 : slot + 1;
        }
        CH_WAIT(0);
    }
#undef CH_DMA
#undef CH_WAIT
}
__device__ __forceinline__ void phase_scan3(const Params& p, const Lt& lt, unsigned char* lds) {
    const int tid = lt.tid, w = __builtin_amdgcn_readfirstlane(tid >> 6);
    const float* SS = (const float*)(p.ws + WS_SS); const float* Z = (const float*)(p.ws + WS_Z); float* yraw = (float*)(p.ws + WS_YRAW);
    const int G = gridDim.x;
#pragma unroll 1
    for (int it = w * G + lt.bid; it < NH * NSEG; it += 8 * G) {
        int lane = tid & 63; asm volatile("" : "+v"(lane));
        const int h = it / NSEG, g = it % NSEG, fi = lane & 15, fq = lane >> 4;
        const float* zb = Z + (size_t)(g * SEGLEN + fi) * RW + h * 64 + fq;
        const float* sb = SS + (size_t)(h * NSEG + g) * 4096 + (size_t)fi * 64 + fq;
        float* yb = yraw + (size_t)(g * SEGLEN + 4 * fq) * RW + h * 64 + fi;
        float bv[4][16];
#pragma unroll
        for (int ti = 0; ti < 4; ++ti)
#pragma unroll
            for (int ks = 0; ks < 16; ++ks) bv[ti][ks] = sb[(size_t)ti * 16 * 64 + 4 * ks];
#pragma unroll 1
        for (int tt = 0; tt < 4; ++tt) {
            float av[16];
#pragma unroll
            for (int ks = 0; ks < 16; ++ks) av[ks] = zb[(size_t)tt * 16 * RW + 4 * ks];
            f32x4 acc[4];
#pragma unroll
            for (int ti = 0; ti < 4; ++ti)
#pragma unroll
                for (int r = 0; r < 4; ++r) acc[ti][r] = yb[(size_t)(tt * 16 + r) * RW + ti * 16];
#pragma unroll
            for (int ks = 0; ks < 16; ++ks)
#pragma unroll
                for (int ti = 0; ti < 4; ++ti) acc[ti] = __builtin_amdgcn_mfma_f32_16x16x4f32(av[ks], bv[ti][ks], acc[ti], 0, 0, 0);
#pragma unroll
            for (int ti = 0; ti < 4; ++ti)
#pragma unroll
                for (int r = 0; r < 4; ++r) yb[(size_t)(tt * 16 + r) * RW + ti * 16] = acc[ti][r];
        }
    }
}

__device__ __forceinline__ void phase_finalize(const Params& p, const Lt& lt, int l) {
    const int tid = lt.tid, lane = tid & 63, w = tid >> 6;
    const float* yraw = (const float*)(p.ws + WS_YRAW); const float* oraw = (const float*)(p.ws + WS_ORAW); const unsigned char* opnd = p.ws + WS_OPND;
    const float* gate = (const float*)(p.ws + WS_GATE); const float* bonus = (const float*)(p.ws + WS_BONUS); const float* ssqa = (const float*)(p.ws + WS_SSQA);
    const float* lg = p.in[12] + l * RW; const float* lb = p.in[13] + l * RW; const float* ang = p.in[15] + l * RW;
    bf16_t* mix = (bf16_t*)(p.ws + WS_MIX);
    for (int t = lt.bid * 8 + w; t < SEQ; t += gridDim.x * 8) {
        const f32x4 sq = *(const f32x4*)(ssqa + (size_t)t * 4);
        const float ra = rsqrtf((sq[0] + sq[1] + sq[2] + sq[3]) * (1.0f / RW) + NORM_EPS);
#pragma unroll
        for (int rnd = 0; rnd < 3; ++rnd) {
            const int c = rnd * 256 + lane * 4, h = c >> 6, cc = c & 63;
            const f32x4 y = *(const f32x4*)(yraw + (size_t)t * RW + c);
            const float m = row16_sum(y[0] + y[1] + y[2] + y[3]) * (1.0f / 64);
            const f32x4 d = y - m;
            const float var = row16_sum(d[0] * d[0] + d[1] * d[1] + d[2] * d[2] + d[3] * d[3]) * (1.0f / 64);
            const float rs = rsqrtf(var + GN_EPS);
            const f32x4 g4 = *(const f32x4*)(lg + c), b4 = *(const f32x4*)(lb + c), v4 = ld_bf4((const bf16_t*)(opnd + (size_t)t * OPTB + h * OPB + 640 + cc * 2)), gt = ld_bf4((const bf16_t*)gate + (size_t)t * RW + c);
            const float bo = bonus[(size_t)t * 16 + h];
            const f32x4 o = (d * rs * g4 + b4 + v4 * bo) * gt;
            u32x2 pk; pk.x = cvt_pk_bf16(o[0], o[1]); pk.y = cvt_pk_bf16(o[2], o[3]);
            *(u32x2*)(mix + (size_t)t * DM + c) = pk;
            const f32x4 oa = *(const f32x4*)(oraw + (size_t)t * RW + c) * ra * *(const f32x4*)(ang + c);
            u32x2 pa; pa.x = cvt_pk_bf16(oa[0], oa[1]); pa.y = cvt_pk_bf16(oa[2], oa[3]);
            *(u32x2*)(mix + (size_t)t * DM + RW + c) = pa;
        }
    }
}

__device__ __forceinline__ void phase_final_norm(const Params& p, const Lt& lt) {
    const int tid = lt.tid, lane = tid & 63, w = tid >> 6;
    const float* x = (const float*)(p.ws + WS_X); const float* ssq = (const float*)(p.ws + WS_SSQ); const float* g = p.in[25];
    for (int t = lt.bid * 8 + w; t < SEQ; t += gridDim.x * 8) {
        const float rs = row_rstd(ssq, t, 1.0f / DM);
#pragma unroll
        for (int i = 0; i < 8; ++i) {
            const int c = i * 256 + lane * 4;
            *(f32x4*)(p.out + (size_t)t * DM + c) = *(const f32x4*)(x + (size_t)t * DM + c) * rs * *(const f32x4*)(g + c);
        }
    }
}

#define XB_TMO      128
#define XB_XCNT(j)  (256  + 64 * (j))
#define XB_XSUB(j)  (1280 + 64 * (j))
#define XB_XGEN(j)  (2304 + 64 * (j))
#define XB_TOP      3328
#define XB_TOPGEN   3392
#define XCD_BAR_WORDS 3456
#define XB_SPIN_CAP (1u << 22)
__device__ __forceinline__ unsigned xb_ld(unsigned* p)              { return __hip_atomic_load(p, __ATOMIC_RELAXED, __HIP_MEMORY_SCOPE_AGENT); }
__device__ __forceinline__ unsigned xb_add(unsigned* p, unsigned v) { return __hip_atomic_fetch_add(p, v, __ATOMIC_RELAXED, __HIP_MEMORY_SCOPE_AGENT); }
__device__ __forceinline__ unsigned xb_xcc_id() { return (unsigned)__builtin_amdgcn_s_getreg((3 << 11) | 20) & 0xFu; }
#define XB_SPIN(cond, bar) do { unsigned _sp = 0; while (cond) { __builtin_amdgcn_s_sleep(1); \
    if ((++_sp & 255u) == 0u) { if (xb_ld(&(bar)[XB_TMO])) break; if (_sp > XB_SPIN_CAP) { atomicAdd(&(bar)[XB_TMO], 1u); break; } } } } while (0)
struct XcdBarrier { unsigned* bar; unsigned x; volatile LAS unsigned* st; };
__device__ __forceinline__ XcdBarrier xcd_barrier_post(unsigned* bar, volatile LAS unsigned* st) {
    XcdBarrier b; b.bar = bar; b.x = xb_xcc_id(); b.st = st;
    if (threadIdx.x == 0) (void)xb_add(&bar[XB_XCNT(b.x)], 1u);
    return b;
}
__device__ __forceinline__ void xcd_barrier_complete(unsigned* bar, unsigned x, unsigned& nloc, unsigned& nx) {
    const unsigned G = gridDim.x * gridDim.y * gridDim.z;
    unsigned sum, cnt, mine, sp = 0u;
    for (;;) {
        sum = 0u; cnt = 0u; mine = 0u;
#pragma unroll
        for (unsigned j = 0; j < 16; ++j) { const unsigned c = xb_ld(&bar[XB_XCNT(j)]); sum += c; cnt += (c > 0u) ? 1u : 0u; mine = (j == x) ? c : mine; }
        if (sum == G) break;
        __builtin_amdgcn_s_sleep(1);
        if ((++sp & 255u) == 0u) { if (xb_ld(&bar[XB_TMO])) break; if (sp > XB_SPIN_CAP) { atomicAdd(&bar[XB_TMO], 1u); break; } }
    }
    nloc = mine > 0u ? mine : 1u; nx = cnt > 0u ? cnt : 1u;
}
__device__ __forceinline__ void xcd_barrier(const XcdBarrier& b) {
    asm volatile("s_waitcnt vmcnt(0)" ::: "memory");
    __syncthreads();
    if (threadIdx.x == 0) {
        unsigned* bar = b.bar;
        __builtin_amdgcn_s_waitcnt(0);
        unsigned nloc = b.st[0], nx = b.st[1];
        if (nloc == 0u) { xcd_barrier_complete(bar, b.x, nloc, nx); b.st[0] = nloc; b.st[1] = nx; }
        const unsigned old = xb_add(&bar[XB_XSUB(b.x)], 1u);
        const unsigned gen = old / nloc;
        if (old + 1u == (gen + 1u) * nloc) {
            __builtin_amdgcn_fence(__ATOMIC_RELEASE, "agent");
            asm volatile("s_waitcnt vmcnt(0)" ::: "memory");
            const unsigned og = xb_add(&bar[XB_TOP], 1u);
            const unsigned tg = og / nx;
            if (og + 1u == (tg + 1u) * nx) xb_add(&bar[XB_TOPGEN], 1u);
            else XB_SPIN(xb_ld(&bar[XB_TOPGEN]) == tg, bar);
            __builtin_amdgcn_fence(__ATOMIC_ACQUIRE, "agent");
            xb_add(&bar[XB_XGEN(b.x)], 1u);
            asm volatile("s_waitcnt vmcnt(0)" ::: "memory");
        } else {
            XB_SPIN(xb_ld(&bar[XB_XGEN(b.x)]) == gen, bar);
            __builtin_amdgcn_fence(__ATOMIC_ACQUIRE, "agent");
            asm volatile("s_waitcnt vmcnt(0)" ::: "memory");
        }
    }
    __syncthreads();
}

constexpr int NPHASE = 2 + 9 * DEPTH;
template <bool COOP>
__global__ void __launch_bounds__(NTHREADS, 2) mega(Params p0) {
    extern __shared__ __attribute__((aligned(16))) unsigned char lds[];
    const int G = gridDim.x;
    XcdBarrier xbar; xbar.bar = nullptr; xbar.x = 0; xbar.st = nullptr;
    if (COOP) {
        volatile LAS unsigned* st = (volatile LAS unsigned*)((LAS unsigned char*)lds + (LDS_BYTES - 16));
        if (threadIdx.x < 4) st[threadIdx.x] = 0u;
        __syncthreads();
        xbar = xcd_barrier_post((unsigned*)(p0.ws + WS_BAR), st);
    }
    for (int ph0 = p0.ph_lo * 2; ph0 < p0.ph_hi * 2; ++ph0) {
        const int ph = ph0 >> 1;
        const int kind = (ph == 0) ? 9 : (ph == NPHASE - 1 ? 10 : (ph - 1) % 9);
        const bool rep = ((MK_REP_MASK >> kind) & 1) != 0;
        if ((ph0 & 1) && !rep) continue;
        Params p = p0; Lt lt; lt.tid = threadIdx.x; lt.bid = blockIdx.x;
        asm volatile("" : "+v"(lt.tid)); asm volatile("" : "+s"(lt.bid));
        { size_t z = 0; asm volatile("" : "+s"(z)); p.ws = p0.ws + z; }
        unsigned char* ws = p.ws;
        if (ph == 0) { if (SEL(0)) phase_prep(p, lt, lds); }
        else if (ph == NPHASE - 1) { if (SEL(1)) phase_final_norm(p, lt); }
        else {
            const int l = (ph - 1) / 9, k = (ph - 1) % 9;
            if (k == 0) { if (SEL(2)) {
                pg8::Gemm g{(const bf16_t*)(ws + WS_XB), (const bf16_t*)(ws + WS_WIN + l * SZ_WIN), SEQ, INC, DM}; pg8::StaticOrder S; S.init(SEQ, INC, G, lt.bid);
                EpiScaleBf16<0> E{(bf16_t*)(ws + WS_P), INC, (const float*)(ws + WS_SSQ)};
                pg8::gemm_phase<true>(lt, (LAS unsigned char*)lds, g, S, E);
                if (G == 256 && lt.bid >= 96 && !(ph0 & 1)) { __syncthreads(); convert_layer(p, lt, l, 864, CONV_TILES, lt.bid - 96, 160, (float*)lds); } }
            } else if (k == 1) {
#pragma unroll 1
                for (int it = lt.bid; it < 256; it += G) {
                    Lt li = lt; asm volatile("" : "+v"(li.tid));
                    if (SEL(4)) rwkv_prep_item(p, li, l, G == 256 ? 2 * (it & 127) + (it >> 7) : it);
                }
            } else if (k == 2) { if (SEL(6)) phase_scan1(p, lt, lds); }
            else if (k == 3) {
                const int nsc = (G >= 192) ? 48 : G;
                if (lt.bid < nsc) { if (SEL(7)) phase_scan2(p, lt, nsc, lds); }
                const int nat = (G >= 192) ? G - 48 : G, b0 = (G >= 192) ? lt.bid - 48 : lt.bid;
                if (b0 >= 0) {
                    if (nat >= 128) {
                        Lt li = lt; asm volatile("" : "+v"(li.tid));
                        if (b0 < 64) { if (SEL(5)) gmlp_item(p, li, l, b0, lds); }
                        else {
#pragma unroll 1
                            for (int it = b0 - 64; it < 256; it += nat - 64) { Lt lj = lt; asm volatile("" : "+v"(lj.tid)); if (SEL(3)) attn_item(p, lj, l, it, lds); }
                        }
                    } else {
#pragma unroll 1
                        for (int it = b0; it < 320; it += nat) {
                            Lt li = lt; asm volatile("" : "+v"(li.tid));
                            if (it < 64) { if (SEL(5)) gmlp_item(p, li, l, it, lds); }
                            else { if (SEL(3)) attn_item(p, li, l, it - 64, lds); }
                        }
                    }
                    if (G == 256 && l + 1 < DEPTH && !(ph0 & 1) && b0 >= 64) convert_layer(p, lt, l + 1, 0, 864, b0 - 64, nat - 64, (float*)lds);
                }
            }
            else if (k == 4) { if (SEL(8)) phase_scan3(p, lt, lds); }
            else if (k == 5) { if (SEL(9)) phase_finalize(p, lt, l); }
            else if (k == 6) { if (SEL(10)) {
                pg8::Gemm g{(const bf16_t*)(ws + WS_MIX), (const bf16_t*)(ws + WS_WOUT + l * SZ_WOUT), SEQ, DM, DM}; pg8::StaticOrder S; S.init(SEQ, DM, G, lt.bid);
                EpiRes E{l == 0 ? p.in[0] : (const float*)(ws + WS_X), (float*)(ws + WS_X), (bf16_t*)(ws + WS_XB), (float*)(ws + WS_SSQ)};
                pg8::gemm_phase<false>(lt, (LAS unsigned char*)lds, g, S, E); }
            } else if (k == 7) { if (SEL(11)) {
                pg8::Gemm g{(const bf16_t*)(ws + WS_XB), (const bf16_t*)(ws + WS_WUP + l * SZ_WUP), SEQ, DFF, DM}; pg8::StaticOrder S; S.init(SEQ, DFF, G, lt.bid);
                EpiScaleBf16<1> E{(bf16_t*)(ws + WS_HB), DFF, (const float*)(ws + WS_SSQ)};
                pg8::gemm_phase<true>(lt, (LAS unsigned char*)lds, g, S, E); }
            } else { if (SEL(12)) {
                pg8::Gemm g{(const bf16_t*)(ws + WS_HB), (const bf16_t*)(ws + WS_WDN + l * SZ_WDN), SEQ, DM, DFF}; pg8::StaticOrder S; S.init(SEQ, DM, G, lt.bid);
                EpiRes E{(const float*)(ws + WS_X), (float*)(ws + WS_X), (bf16_t*)(ws + WS_XB), (float*)(ws + WS_SSQ)};
                pg8::gemm_phase<false>(lt, (LAS unsigned char*)lds, g, S, E); }
            }
        }
        if (COOP) { const bool lastexec = (ph + 1 == p0.ph_hi) && ((ph0 & 1) || !rep); if (!lastexec) { if (p0.ph_hi > NPHASE) cg::this_grid().sync(); else xcd_barrier(xbar); } }
    }
}

extern "C" void kernel_launch(void* const* d_in, const int* in_sizes, int n_in, void* d_out, int out_size, void* d_ws, size_t ws_size, hipStream_t stream) {
    static int grid = 0;
    if (grid == 0) {
        if (n_in != 26 || ws_size < WS_END) { fprintf(stderr, "kernel_launch: unexpected inputs (%d) or workspace (%zu < %zu)\n", n_in, ws_size, (size_t)WS_END); grid = -1; return; }
        int dev = 0, cus = 0, per_cu = 0;
        hipGetDevice(&dev);
        hipDeviceGetAttribute(&cus, hipDeviceAttributeMultiprocessorCount, dev);
        hipFuncSetAttribute((const void*)mega<MK_COOP != 0>, hipFuncAttributeMaxDynamicSharedMemorySize, LDS_BYTES);
        hipOccupancyMaxActiveBlocksPerMultiprocessor(&per_cu, (const void*)mega<MK_COOP != 0>, NTHREADS, LDS_BYTES);
        per_cu = 1;
        grid = cus * per_cu;
        (void)hipGetLastError();
    }
    if (grid < 0) return;
    Params p{};
    for (int i = 0; i < 26; ++i) p.in[i] = (const float*)d_in[i];
    p.out = (float*)d_out; p.ws = (unsigned char*)d_ws;
#if MK_COOP
    p.ph_lo = 0; p.ph_hi = NPHASE;
    (void)hipMemsetAsync((unsigned char*)d_ws + WS_BAR, 0, 16384, stream);
    void* args[] = {&p};
    hipError_t e = hipLaunchCooperativeKernel((const void*)mega<true>, dim3(grid), dim3(NTHREADS), args, LDS_BYTES, stream);
    if (e != hipSuccess) fprintf(stderr, "cooperative launch failed: %s (grid %d)\n", hipGetErrorString(e), grid);
#else
    for (int ph = 0; ph < NPHASE; ++ph) {
        p.ph_lo = ph; p.ph_hi = ph + 1;
        hipLaunchKernelGGL(mega<false>, dim3(grid), dim3(NTHREADS), LDS_BYTES, stream, p);
    }
#endif
}
```

```cpp
#include <hip/hip_runtime.h>
#include <hip/hip_cooperative_groups.h>
#include <cstdio>
namespace cg = cooperative_groups;

#ifndef MK_COOP
#define MK_COOP 1
#endif
#ifndef MK_REP_MASK
#define MK_REP_MASK 0
#endif
#ifndef MK_ONLY
#define MK_ONLY -1
#endif
#define SEL(x) (MK_ONLY < 0 || MK_ONLY == (x))

#define LAS __attribute__((address_space(3)))
typedef unsigned short bf16_t;
typedef short bf16x8 __attribute__((ext_vector_type(8)));
typedef float f32x4 __attribute__((ext_vector_type(4)));
typedef float f32x2 __attribute__((ext_vector_type(2)));
typedef unsigned u32x4 __attribute__((ext_vector_type(4)));
typedef unsigned u32x2 __attribute__((ext_vector_type(2)));

constexpr int SEQ = 8192, DM = 2048, DEPTH = 4, INC = 4864, DFF = 8192;
constexpr int RW = 768, NH = 12;
constexpr int COL_K = 768, COL_V = 1536, COL_XW = 2304, COL_XA = 2368, COL_XG = 2432;
constexpr int COL_AQ = 2560, COL_AK = 3328, COL_AV = 3584, COL_GU = 3840, COL_GZ = 4352;
constexpr float NORM_EPS = 1e-6f, GN_EPS = 64e-5f;
constexpr int SEGLEN = 64, NSEG = SEQ / SEGLEN;
constexpr int OPB = 896, OPTB = NH * OPB;
constexpr int NTHREADS = 512;
constexpr int LDS_BYTES = 147456;

constexpr size_t SZ_WIN = (size_t)INC * DM * 2, SZ_WOUT = (size_t)DM * DM * 2, SZ_WUP = (size_t)DFF * DM * 2, SZ_WDN = (size_t)DM * DFF * 2;
constexpr size_t SZ_LORA = 524288;
constexpr size_t WS_WIN = 0;
constexpr size_t WS_WOUT = WS_WIN + DEPTH * SZ_WIN;
constexpr size_t WS_WUP = WS_WOUT + DEPTH * SZ_WOUT;
constexpr size_t WS_WDN = WS_WUP + DEPTH * SZ_WUP;
constexpr size_t WS_LORA = WS_WDN + DEPTH * SZ_WDN;
constexpr size_t WS_X = WS_LORA + DEPTH * SZ_LORA;
constexpr size_t WS_XB = WS_X + (size_t)SEQ * DM * 4;
constexpr size_t WS_SSQ = WS_XB + (size_t)SEQ * DM * 2;
constexpr size_t WS_MIX = WS_SSQ + (size_t)SEQ * 32 * 4;
constexpr size_t WS_U = WS_MIX + (size_t)SEQ * DM * 2;
constexpr size_t WS_P = WS_U;
constexpr size_t WS_OPND = WS_P + (size_t)SEQ * INC * 2;
constexpr size_t WS_GATE = WS_OPND + (size_t)SEQ * OPTB;
constexpr size_t WS_BONUS = WS_GATE + (size_t)SEQ * RW * 4;
constexpr size_t WS_YRAW = WS_BONUS + (size_t)SEQ * 16 * 4;
constexpr size_t WS_ORAW = WS_YRAW + (size_t)SEQ * RW * 4;
constexpr size_t WS_SSQA = WS_ORAW + (size_t)SEQ * RW * 4;
constexpr size_t WS_TG = WS_SSQA + (size_t)SEQ * 4 * 4;
constexpr size_t WS_LG = WS_TG + (size_t)NH * NSEG * 4096 * 4;
constexpr size_t WS_SS = WS_LG + (size_t)NH * NSEG * 4096 * 4;
constexpr size_t WS_GRAW = WS_SS + (size_t)NH * NSEG * 4096 * 4;
constexpr size_t WS_Z = WS_GRAW + (size_t)SEQ * 512 * 4;
constexpr size_t WS_BAR = WS_Z + (size_t)SEQ * RW * 4;
constexpr size_t WS_END_MIX = WS_BAR + 16384;
constexpr size_t WS_HB = WS_U;
constexpr size_t WS_END = WS_END_MIX;
static_assert(WS_HB + (size_t)SEQ * DFF * 2 <= WS_END, "ffn buffer fits the union");
static_assert(WS_END <= (size_t)1073741824, "workspace budget");

struct Params { const float* in[26]; float* out; unsigned char* ws; int ph_lo, ph_hi; };
struct Lt { int tid, bid; };

typedef __bf16 bf16x2_t __attribute__((ext_vector_type(2)));
__device__ __forceinline__ unsigned cvt_pk_bf16(float lo, float hi) { const f32x2 v = {lo, hi}; return __builtin_bit_cast(unsigned, __builtin_convertvector(v, bf16x2_t)); }
__device__ __forceinline__ float bflo(unsigned u) { return __uint_as_float(u << 16); }
__device__ __forceinline__ float bfhi(unsigned u) { return __uint_as_float(u & 0xffff0000u); }
__device__ __forceinline__ void lds_barrier() { asm volatile("s_waitcnt lgkmcnt(0)" ::: "memory"); __builtin_amdgcn_s_barrier(); asm volatile("" ::: "memory"); }
__device__ __forceinline__ float xor16(float v) { return __shfl_xor(v, 16); }
__device__ __forceinline__ float xor32(float v) { return __shfl_xor(v, 32); }
__device__ __forceinline__ float quad_sum(float v) { v += xor16(v); v += xor32(v); return v; }
__device__ __forceinline__ float row16_sum(float v) { v += __shfl_xor(v, 1); v += __shfl_xor(v, 2); v += __shfl_xor(v, 4); v += __shfl_xor(v, 8); return v; }
__device__ __forceinline__ float gelu_exact(float v) {
    const float av = fabsf(v), t = __builtin_amdgcn_rcpf(av * 0.2316418882f + 1.0f);
    float q = t * 0.5307027145f + (-0.7265760135f); q = q * t + 0.7107068705f; q = q * t + (-0.142248368f); q = q * t + 0.127414796f; q = q * t;
    const float e = __builtin_amdgcn_exp2f((v * v) * (-0.72134752044f));
    const float m = v * (q * e);
    return v < 0.f ? m : v - m;
}
__device__ __forceinline__ float sigmoidf_(float x) { return __builtin_amdgcn_rcpf(1.0f + __expf(-x)); }
__device__ __forceinline__ float tanhf_(float x) { return 1.0f - 2.0f * __builtin_amdgcn_rcpf(1.0f + __expf(2.0f * x)); }
__device__ __forceinline__ float row_rstd(const float* ssq, int row, float inv_n) {
    const f32x4* p = (const f32x4*)(ssq + (size_t)row * 32);
    f32x4 s = p[0];
#pragma unroll
    for (int i = 1; i < 8; ++i) s += p[i];
    return rsqrtf((s[0] + s[1] + s[2] + s[3]) * inv_n + NORM_EPS);
}

namespace pg8 {
constexpr int BM = 256, BK = 64, HALF = 128, HTB = HALF * BK * 2, STAGE_BYTES = 8 * HTB, NXCD = 8, WGM = 8;
__host__ __device__ __forceinline__ int lds_byte(int r, int c) { const int st = (r >> 4) * 2 + (c >> 5), rr = r & 15, cc = c & 31, ob = rr * 64 + cc * 2; return st * 1024 + (ob ^ (((ob >> 9) & 1) << 5)); }
__host__ __device__ __forceinline__ void stage_rc(int b, int& R, int& C) { const int st = b / 1024, sb = b % 1024, swz = sb ^ (((sb >> 9) & 1) << 5); R = (st >> 1) * 16 + swz / 64; C = (st & 1) * 32 + (swz % 64) / 2; }
__host__ __device__ __forceinline__ int perm32(int rho) { const int n = rho >> 4, i = rho & 15; return 8 * (i >> 2) + 4 * n + (i & 3); }
struct Unit { int pm, pn; };
struct Gemm { const bf16_t* A; const bf16_t* Bt; int M, N, K; };
struct StaticOrder {
    int nM, nN, nwg, G, c;
    __device__ void init(int M, int N, int G_, int c_) { nM = M / BM; nN = N / BM; nwg = nM * nN; G = G_; c = c_; }
    __device__ bool next(int i, Unit& u) const {
        const long L = (long)i * G + c; if (L >= nwg) return false;
        int wgid = (int)L; { const int q = nwg / NXCD, r = nwg % NXCD, xcd = wgid % NXCD, off = wgid / NXCD; wgid = (xcd < r ? xcd * (q + 1) : r * (q + 1) + (xcd - r) * q) + off; }
        const int nig = WGM * nN, gid = wgid / nig, fm = gid * WGM, gsz = (nM - fm) < WGM ? (nM - fm) : WGM;
        u.pm = fm + ((wgid % nig) % gsz); u.pn = (wgid % nig) / gsz; return true;
    }
};
template <class Epi>
__device__ __forceinline__ void gemm_phase(const Lt& lt, LAS unsigned char* lds, const Gemm g, const StaticOrder& S, const Epi& E) {
    const int tid = lt.tid, wid = __builtin_amdgcn_readfirstlane(tid >> 6), lane = tid & 63, wr = wid >> 2, wc = wid & 3, fr = lane & 15, fq = lane >> 4;
    const int K = g.K, nt = K / BK;
    unsigned voffA[2], voffB[2];
#pragma unroll
    for (int i = 0; i < 2; ++i) { int R, C; stage_rc(tid * 16 + i * 8192, R, C); const int Rb = (R & ~31) + perm32(R & 31);
        voffA[i] = (unsigned)(R * K + C) * 2u; voffB[i] = (unsigned)(Rb * K + C) * 2u; }
    const size_t kstep = (size_t)(BK * 2);
    const size_t hstep = (size_t)HALF * K * 2;
    const size_t tstep = 2 * hstep;
    const unsigned ldsw = (unsigned)wid * 1024u;
    const int aoff = lds_byte(wr * 64 + fr, fq * 8), boff = lds_byte(wc * 32 + fr, fq * 8);
#define PG8_SA(b, h) (((b) * 2 + (h)) * HTB)
#define PG8_SB(b, h) ((4 + (b) * 2 + (h)) * HTB)
#define PG8_STAGE(bufoff, gbase, voff) do { _Pragma("unroll") for (int _i = 0; _i < 2; ++_i) \
        __builtin_amdgcn_global_load_lds((const unsigned*)((const char*)(gbase) + (voff)[_i]), (LAS unsigned*)(lds + (bufoff) + ldsw + _i * 8192), 16, 0, 0); } while (0)
#define PG8_LDA(dst, b, h) do { _Pragma("unroll") for (int m = 0; m < 4; ++m) _Pragma("unroll") for (int k = 0; k < 2; ++k) dst[m][k] = *(const LAS bf16x8*)(lds + PG8_SA(b, h) + aoff + m * 2048 + k * 1024); } while (0)
#define PG8_LDB(dst, b, h) do { _Pragma("unroll") for (int n = 0; n < 2; ++n) _Pragma("unroll") for (int k = 0; k < 2; ++k) dst[n][k] = *(const LAS bf16x8*)(lds + PG8_SB(b, h) + boff + n * 2048 + k * 1024); } while (0)
#define PG8_MMA(ai, bj, At, Bt) do { __builtin_amdgcn_s_setprio(2); _Pragma("unroll") for (int m = 0; m < 4; ++m) _Pragma("unroll") for (int n = 0; n < 2; ++n) _Pragma("unroll") for (int k = 0; k < 2; ++k) \
        acc[ai][bj][m][n] = __builtin_amdgcn_mfma_f32_16x16x32_bf16(Bt[n][k], At[m][k], acc[ai][bj][m][n], 0, 0, 0); __builtin_amdgcn_s_setprio(0); } while (0)
#define PG8_WAIT_V(n) asm volatile("s_waitcnt vmcnt(" #n ")" ::: "memory")
#define PG8_WAIT_L(n) asm volatile("s_waitcnt lgkmcnt(" #n ")" ::: "memory")
#define PG8_BAR __builtin_amdgcn_s_barrier()
#define PG8_SCHED __builtin_amdgcn_sched_barrier(0)
    Unit cur, nxt; int ui = 0;
    if (!S.next(0, cur)) return;
    { Unit uu; for (int i = 0; i < 8 && S.next(i, uu); ++i) E.prepare(uu, lds, i, tid); }
    f32x4 acc[2][2][4][2];
#pragma unroll
    for (int a = 0; a < 2; ++a)
#pragma unroll
        for (int b = 0; b < 2; ++b)
#pragma unroll
            for (int m = 0; m < 4; ++m)
#pragma unroll
                for (int n = 0; n < 2; ++n) acc[a][b][m][n] = (f32x4){0.f, 0.f, 0.f, 0.f};
    bf16x8 At[4][2], B0[2][2], B1[2][2];
    const char* cA = (const char*)g.A + (size_t)cur.pm * tstep; const char* cB = (const char*)g.Bt + (size_t)cur.pn * tstep;
    PG8_STAGE(PG8_SB(0, 0), cB, voffB); PG8_STAGE(PG8_SB(0, 1), cB + hstep, voffB); PG8_STAGE(PG8_SA(0, 0), cA, voffA); PG8_STAGE(PG8_SA(0, 1), cA + hstep, voffA);
    if (wr == 1) PG8_BAR;
    PG8_WAIT_V(2); PG8_BAR;
    PG8_STAGE(PG8_SB(1, 0), cB + kstep, voffB); PG8_STAGE(PG8_SA(1, 0), cA + kstep, voffA); PG8_STAGE(PG8_SB(1, 1), cB + hstep + kstep, voffB);
    PG8_WAIT_V(6); PG8_BAR;
    for (;;) {
        const bool has_next = S.next(ui + 1, nxt);
        const char* nA = has_next ? (const char*)g.A + (size_t)nxt.pm * tstep : cA; const char* nB = has_next ? (const char*)g.Bt + (size_t)nxt.pn * tstep : cB;
        for (int t = 0; t < nt; t += 2) {
            const bool last = (t == nt - 2);
            const char* a1 = cA + (size_t)(t + 1) * kstep;
            const char* a2 = last ? nA : cA + (size_t)(t + 2) * kstep; const char* b2 = last ? nB : cB + (size_t)(t + 2) * kstep;
            const char* a3 = a2 + kstep; const char* b3 = b2 + kstep;
            PG8_LDB(B0, 0, 0); PG8_LDB(B1, 0, 1); PG8_SCHED; PG8_LDA(At, 0, 0); PG8_STAGE(PG8_SA(1, 1), a1 + hstep, voffA);
            PG8_WAIT_V(8); PG8_WAIT_L(0); PG8_BAR; PG8_MMA(0, 0, At, B0); PG8_MMA(0, 1, At, B1); PG8_BAR; PG8_SCHED;
            PG8_LDA(At, 0, 1); PG8_STAGE(PG8_SB(0, 0), b2, voffB); PG8_STAGE(PG8_SB(0, 1), b2 + hstep, voffB); PG8_STAGE(PG8_SA(0, 0), a2, voffA);
            PG8_WAIT_V(8); PG8_WAIT_L(0); PG8_BAR; PG8_MMA(1, 0, At, B0); PG8_MMA(1, 1, At, B1); PG8_BAR; PG8_SCHED;
            PG8_LDB(B0, 1, 0); PG8_LDB(B1, 1, 1); PG8_SCHED; PG8_LDA(At, 1, 0); PG8_STAGE(PG8_SA(0, 1), a2 + hstep, voffA);
            PG8_WAIT_V(8); PG8_WAIT_L(0); PG8_BAR; PG8_MMA(0, 0, At, B0); PG8_MMA(0, 1, At, B1); PG8_BAR; PG8_SCHED;
            PG8_LDA(At, 1, 1); PG8_STAGE(PG8_SB(1, 0), b3, voffB); PG8_STAGE(PG8_SB(1, 1), b3 + hstep, voffB); PG8_STAGE(PG8_SA(1, 0), a3, voffA);
            PG8_WAIT_V(8); PG8_WAIT_L(0); PG8_BAR; PG8_MMA(1, 0, At, B0); PG8_MMA(1, 1, At, B1); PG8_BAR; PG8_SCHED;
        }
        E(acc, cur, wr, wc, fr, fq, lds, ui & 7);
        if (!has_next) break;
        if (ui + 1 >= 8) E.prepare(nxt, lds, (ui + 1) & 7, tid);
#pragma unroll
        for (int a = 0; a < 2; ++a)
#pragma unroll
            for (int b = 0; b < 2; ++b)
#pragma unroll
                for (int m = 0; m < 4; ++m)
#pragma unroll
                    for (int n = 0; n < 2; ++n) acc[a][b][m][n] = (f32x4){0.f, 0.f, 0.f, 0.f};
        cur = nxt; cA = nA; cB = nB; ++ui;
    }
    PG8_WAIT_V(0);
    if (wr == 0) PG8_BAR;
    PG8_BAR;
#undef PG8_SA
#undef PG8_SB
#undef PG8_STAGE
#undef PG8_LDA
#undef PG8_LDB
#undef PG8_MMA
#undef PG8_WAIT_V
#undef PG8_WAIT_L
#undef PG8_BAR
#undef PG8_SCHED
}
}

template <int ACT> struct EpiScaleBf16 {
    bf16_t* O; int ldc; const float* ssq;
    __device__ __forceinline__ void prepare(const pg8::Unit& u, LAS unsigned char* lds, int buf, int tid) const {
        if (tid < 256) ((LAS float*)(lds + pg8::STAGE_BYTES))[buf * 256 + tid] = row_rstd(ssq, u.pm * 256 + tid, 1.0f / DM);
    }
    __device__ __forceinline__ void operator()(const f32x4 (&acc)[2][2][4][2], const pg8::Unit& u, int wr, int wc, int fr, int fq, LAS unsigned char* lds, int buf) const {
        const int row0 = u.pm * 256 + wr * 64 + fr, col0 = u.pn * 256 + wc * 32 + 8 * fq;
        const LAS float* rst = (const LAS float*)(lds + pg8::STAGE_BYTES) + buf * 256 + wr * 64 + fr;
        float rs[2][4];
#pragma unroll
        for (int ai = 0; ai < 2; ++ai)
#pragma unroll
            for (int m = 0; m < 4; ++m) rs[ai][m] = rst[ai * 128 + m * 16];
#pragma unroll
        for (int ai = 0; ai < 2; ++ai)
#pragma unroll
            for (int m = 0; m < 4; ++m) {
                const int row = row0 + ai * 128 + m * 16;
                bf16_t* rowp = O + (size_t)row * ldc + col0;
#pragma unroll
                for (int bj = 0; bj < 2; ++bj) {
                    f32x4 v0 = acc[ai][bj][m][0] * rs[ai][m], v1 = acc[ai][bj][m][1] * rs[ai][m];
                    if (ACT == 1) {
#pragma unroll
                        for (int j = 0; j < 4; ++j) { const float a = fmaxf(v0[j], 0.f), b = fmaxf(v1[j], 0.f); v0[j] = a * a; v1[j] = b * b; }
                    }
                    u32x4 w; w.x = cvt_pk_bf16(v0[0], v0[1]); w.y = cvt_pk_bf16(v0[2], v0[3]); w.z = cvt_pk_bf16(v1[0], v1[1]); w.w = cvt_pk_bf16(v1[2], v1[3]);
                    *(u32x4*)(rowp + bj * 128) = w;
                }
            }
    }
};
struct EpiRes {
    const float* xsrc; float* xdst; bf16_t* xb; float* ssq;
    __device__ __forceinline__ void prepare(const pg8::Unit&, LAS unsigned char*, int, int) const {}
    __device__ __forceinline__ void operator()(const f32x4 (&acc)[2][2][4][2], const pg8::Unit& u, int wr, int wc, int fr, int fq, LAS unsigned char*, int) const {
        const int row0 = u.pm * 256 + wr * 64 + fr, col0 = u.pn * 256 + wc * 32 + 8 * fq;
#pragma unroll
        for (int ai = 0; ai < 2; ++ai) {
            f32x4 xv[4][2][2];
#pragma unroll
            for (int m = 0; m < 4; ++m) {
                const size_t ro = (size_t)(row0 + ai * 128 + m * 16) * DM + col0;
#pragma unroll
                for (int bj = 0; bj < 2; ++bj) { xv[m][bj][0] = *(const f32x4*)(xsrc + ro + bj * 128); xv[m][bj][1] = *(const f32x4*)(xsrc + ro + bj * 128 + 4); }
            }
#pragma unroll
            for (int m = 0; m < 4; ++m) {
                const int row = row0 + ai * 128 + m * 16;
                const size_t ro = (size_t)row * DM + col0;
                float part = 0.f;
#pragma unroll
                for (int bj = 0; bj < 2; ++bj) {
                    const f32x4 v0 = xv[m][bj][0] + acc[ai][bj][m][0], v1 = xv[m][bj][1] + acc[ai][bj][m][1];
                    *(f32x4*)(xdst + ro + bj * 128) = v0; *(f32x4*)(xdst + ro + bj * 128 + 4) = v1;
                    u32x4 w; w.x = cvt_pk_bf16(v0[0], v0[1]); w.y = cvt_pk_bf16(v0[2], v0[3]); w.z = cvt_pk_bf16(v1[0], v1[1]); w.w = cvt_pk_bf16(v1[2], v1[3]);
                    *(u32x4*)(xb + ro + bj * 128) = w;
#pragma unroll
                    for (int j = 0; j < 4; ++j) part += v0[j] * v0[j] + v1[j] * v1[j];
                }
                part = quad_sum(part);
                if (fq == 0) ssq[(size_t)row * 32 + u.pn * 4 + wc] = part;
            }
        }
    }
};

__device__ __forceinline__ void transpose_job(const Lt& lt, const float* src, bf16_t* dst, const float* scale, int K, int N, int& rot, float* tile  ) {
    const int tid = lt.tid, G = gridDim.x;
    const int tk = K / 64, tn = N / 64, ntile = tk * tn;
    const int first = (int)((lt.bid + G - (rot % G)) % G);
    for (int t = first; t < ntile; t += G) {
        const int k0 = (t / tn) * 64, n0 = (t % tn) * 64;
        { const int kr = tid >> 4, nc = (tid & 15) * 4;
#pragma unroll
          for (int h = 0; h < 2; ++h) { const f32x4 v = *(const f32x4*)(src + (size_t)(k0 + kr + h * 32) * N + n0 + nc);
              float* tp = tile + (kr + h * 32) * 65 + nc; tp[0] = v[0]; tp[1] = v[1]; tp[2] = v[2]; tp[3] = v[3]; } }
        __syncthreads();
        { const int n = tid >> 3, kc = (tid & 7) * 8; float v[8];
#pragma unroll
          for (int i = 0; i < 8; ++i) v[i] = tile[(kc + i) * 65 + n];
          if (scale) {
#pragma unroll
              for (int i = 0; i < 8; ++i) v[i] *= scale[k0 + kc + i]; }
          u32x4 w; w.x = cvt_pk_bf16(v[0], v[1]); w.y = cvt_pk_bf16(v[2], v[3]); w.z = cvt_pk_bf16(v[4], v[5]); w.w = cvt_pk_bf16(v[6], v[7]);
          *(u32x4*)(dst + (size_t)(n0 + n) * K + k0 + kc) = w; }
        __syncthreads();
    }
    rot += ntile;
}

__device__ __forceinline__ void transpose_big(const Lt& lt, const float* src, bf16_t* dst, const float* scale, int K, int N, int tlo, int thi, int phase, int c, int nc, float* tile) {
    const int tid = lt.tid;
    const int tn = N / 128;
    const int first = tlo + (((c - (tlo + phase)) % nc) + nc) % nc;
    const int kr = tid >> 5, nc4 = (tid & 31) * 4;
    const int on = tid & 127, okc = (tid >> 7) * 32;
    f32x4 pre[8];
    if (first < thi) { const int k0 = (first / tn) * 128, n0 = (first % tn) * 128;
#pragma unroll
        for (int h = 0; h < 8; ++h) pre[h] = __builtin_nontemporal_load((const f32x4*)(src + (size_t)(k0 + kr + 16 * h) * N + n0 + nc4)); }
#pragma unroll 1
    for (int t = first; t < thi; t += nc) {
        const int k0 = (t / tn) * 128, n0 = (t % tn) * 128;
#pragma unroll
        for (int h = 0; h < 8; ++h) { float* tp = tile + (kr + 16 * h) * 129 + nc4; tp[0] = pre[h][0]; tp[1] = pre[h][1]; tp[2] = pre[h][2]; tp[3] = pre[h][3]; }
        lds_barrier();
        const int tnx = t + nc;
        if (tnx < thi) { const int k1 = (tnx / tn) * 128, n1 = (tnx % tn) * 128;
#pragma unroll
            for (int h = 0; h < 8; ++h) pre[h] = __builtin_nontemporal_load((const f32x4*)(src + (size_t)(k1 + kr + 16 * h) * N + n1 + nc4)); }
        bf16_t* dp = dst + (size_t)(n0 + on) * K + k0 + okc;
#pragma unroll
        for (int q = 0; q < 4; ++q) {
            float v[8];
#pragma unroll
            for (int i = 0; i < 8; ++i) v[i] = tile[(okc + q * 8 + i) * 129 + on];
            if (scale) {
                const f32x4 s0 = *(const f32x4*)(scale + k0 + okc + q * 8), s1 = *(const f32x4*)(scale + k0 + okc + q * 8 + 4);
#pragma unroll
                for (int i = 0; i < 4; ++i) { v[i] *= s0[i]; v[4 + i] *= s1[i]; }
            }
            u32x4 w; w.x = cvt_pk_bf16(v[0], v[1]); w.y = cvt_pk_bf16(v[2], v[3]); w.z = cvt_pk_bf16(v[4], v[5]); w.w = cvt_pk_bf16(v[6], v[7]);
            *(u32x4*)(dp + q * 8) = w;
        }
        lds_barrier();
    }
}
constexpr int CONV_TILES = 2912;
__device__ __forceinline__ void convert_layer(const Params& p, const Lt& lt, int l, int glo, int ghi, int c, int nc, float* tile) {
    unsigned char* ws = p.ws;
#pragma unroll 1
    for (int m = 0; m < 4; ++m) {
        const int off = m == 0 ? 0 : (m == 1 ? 608 : (m == 2 ? 864 : 1888)), n = m == 0 ? 608 : (m == 1 ? 256 : 1024);
        const int lo = (glo > off ? glo : off) - off, hi = (ghi < off + n ? ghi : off + n) - off;
        if (lo >= hi) continue;
        const float* src = m == 0 ? p.in[2] + (size_t)l * DM * INC : (m == 1 ? p.in[21] + (size_t)l * DM * DM : (m == 2 ? p.in[23] + (size_t)l * DM * DFF : p.in[24] + (size_t)l * DFF * DM));
        bf16_t* dst = (bf16_t*)(m == 0 ? ws + WS_WIN + l * SZ_WIN : (m == 1 ? ws + WS_WOUT + l * SZ_WOUT : (m == 2 ? ws + WS_WUP + l * SZ_WUP : ws + WS_WDN + l * SZ_WDN)));
        const float* scale = m == 0 ? p.in[1] + l * DM : (m == 2 ? p.in[22] + l * DM : nullptr);
        const int K = m == 3 ? DFF : DM, N = m == 0 ? INC : (m == 2 ? DFF : DM);
        transpose_big(lt, src, dst, scale, K, N, lo, hi, off - glo, c, nc, tile);
    }
}

__device__ __forceinline__ void phase_prep(const Params& p, const Lt& lt, unsigned char* lds) {
    float* tile = (float*)lds;
    unsigned char* ws = p.ws;
    int rot = 0;
    if (gridDim.x == 256) convert_layer(p, lt, 0, 0, 864, lt.bid, gridDim.x, tile);
    else for (int l = 0; l < DEPTH; ++l) convert_layer(p, lt, l, 0, CONV_TILES, lt.bid, gridDim.x, tile);
    for (int l = 0; l < DEPTH; ++l) {
        bf16_t* lora = (bf16_t*)(ws + WS_LORA + l * SZ_LORA);
        transpose_job(lt, p.in[5] + (size_t)l * 64 * RW, lora, nullptr, 64, RW, rot, tile);
        transpose_job(lt, p.in[7] + (size_t)l * 64 * RW, lora + 49152, nullptr, 64, RW, rot, tile);
        transpose_job(lt, p.in[8] + (size_t)l * 128 * RW, lora + 98304, nullptr, 128, RW, rot, tile);
    }
    const int gtid = lt.bid * NTHREADS + lt.tid, gsz = gridDim.x * NTHREADS;
    for (int i = gtid; i < DEPTH * 4 * 128 * 128 / 2; i += gsz) {
        const int e = i * 2, l = e >> 16, r = e & 65535, t = (r >> 7) & 127, s = r & 127;
        const float a = p.in[18][e], b = p.in[18][e + 1];
        bf16_t* dst = (bf16_t*)(ws + WS_LORA + l * SZ_LORA) + 196608;
        *(unsigned*)(dst + r) = cvt_pk_bf16(s <= t ? a : 0.f, (s + 1) <= t ? b : 0.f);
    }
    const int wave = gtid >> 6, nwave = gsz >> 6, lane = lt.tid & 63;
    const float* x = p.in[0]; bf16_t* xb = (bf16_t*)(ws + WS_XB); float* ssq = (float*)(ws + WS_SSQ);
    for (int row = wave; row < SEQ; row += nwave) {
        float s = 0.f;
#pragma unroll
        for (int i = 0; i < 4; ++i) {
            const size_t o = (size_t)row * DM + i * 512 + lane * 8;
            const f32x4 a = *(const f32x4*)(x + o), b = *(const f32x4*)(x + o + 4);
            u32x4 w; w.x = cvt_pk_bf16(a[0], a[1]); w.y = cvt_pk_bf16(a[2], a[3]); w.z = cvt_pk_bf16(b[0], b[1]); w.w = cvt_pk_bf16(b[2], b[3]);
            *(u32x4*)(xb + o) = w;
#pragma unroll
            for (int j = 0; j < 4; ++j) s += a[j] * a[j] + b[j] * b[j];
        }
#pragma unroll
        for (int o = 32; o > 0; o >>= 1) s += __shfl_xor(s, o);
        if (lane < 32) ssq[(size_t)row * 32 + lane] = (lane == 0) ? s : 0.f;
    }
}

__device__ __forceinline__ void attn_item(const Params& p, const Lt& lt, int l, int item, unsigned char* lds) {
    const int tid = lt.tid, lane = tid & 63, w = __builtin_amdgcn_readfirstlane(tid >> 6), qi = lane & 15, quad = lane >> 4;
    const int nb = item >> 2, kvh = item & 3;
    const bf16_t* P = (const bf16_t*)(p.ws + WS_P);
    bf16_t* Kl = (bf16_t*)lds;
    bf16_t* VT = (bf16_t*)(lds + 36864);
    for (int u = tid; u < 2048; u += NTHREADS) {
        const int row = u >> 3, part = u & 7, tok = (nb - 1) * 128 + row;
        u32x4 kv = {0u, 0u, 0u, 0u}, vv = {0u, 0u, 0u, 0u};
        if (tok >= 0) { kv = *(const u32x4*)(P + (size_t)tok * INC + COL_AK + kvh * 64 + part * 8); vv = *(const u32x4*)(P + (size_t)tok * INC + COL_AV + kvh * 64 + part * 8); }
        *(u32x4*)(Kl + row * 72 + part * 8) = kv;
#pragma unroll
        for (int i = 0; i < 4; ++i) { VT[(part * 8 + 2 * i) * 264 + row] = (bf16_t)(vv[i] & 0xffffu); VT[(part * 8 + 2 * i + 1) * 264 + row] = (bf16_t)(vv[i] >> 16); }
    }
    __syncthreads();
    const int tok = nb * 128 + w * 16 + qi;
    float* oraw = (float*)(p.ws + WS_ORAW);
    float ssq = 0.f;
    for (int hq = 0; hq < 3; ++hq) {
        const int head = kvh * 3 + hq;
        const float sink = p.in[14][l * 12 + head];
        bf16x8 qf[2];
#pragma unroll
        for (int ks = 0; ks < 2; ++ks) qf[ks] = *(const bf16x8*)(P + (size_t)tok * INC + COL_AQ + head * 64 + ks * 32 + quad * 8);
        f32x4 sacc[9];
        float mx = sink;
#pragma unroll
        for (int rt = 0; rt < 9; ++rt) {
            const int key = (w + rt) * 16 + qi;
            f32x4 a = {0.f, 0.f, 0.f, 0.f};
#pragma unroll
            for (int ks = 0; ks < 2; ++ks) { const bf16x8 kf = *(const bf16x8*)(Kl + key * 72 + ks * 32 + quad * 8); a = __builtin_amdgcn_mfma_f32_16x16x32_bf16(kf, qf[ks], a, 0, 0, 0); }
#pragma unroll
            for (int j = 0; j < 4; ++j) {
                const int jk = (w + rt) * 16 + quad * 4 + j, i = w * 16 + qi;
                const bool valid = (jk > i) && (jk <= i + 128) && (nb > 0 || jk >= 128);
                const float s = valid ? a[j] * 0.125f : -1e30f;
                a[j] = s; mx = fmaxf(mx, s);
            }
            sacc[rt] = a;
        }
        mx = fmaxf(mx, xor16(mx)); mx = fmaxf(mx, xor32(mx));
        float lsum = 0.f;
#pragma unroll
        for (int rt = 0; rt < 9; ++rt)
#pragma unroll
            for (int j = 0; j < 4; ++j) { const float e = __expf(sacc[rt][j] - mx); sacc[rt][j] = e; lsum += e; }
        lsum = quad_sum(lsum) + __expf(sink - mx);
        f32x4 oacc[4];
#pragma unroll
        for (int dt = 0; dt < 4; ++dt) oacc[dt] = (f32x4){0.f, 0.f, 0.f, 0.f};
#pragma unroll
        for (int kb = 0; kb < 5; ++kb) {
            u32x4 pw; pw.x = cvt_pk_bf16(sacc[2 * kb][0], sacc[2 * kb][1]); pw.y = cvt_pk_bf16(sacc[2 * kb][2], sacc[2 * kb][3]);
            if (kb < 4) { pw.z = cvt_pk_bf16(sacc[(2 * kb + 1) % 9][0], sacc[(2 * kb + 1) % 9][1]); pw.w = cvt_pk_bf16(sacc[(2 * kb + 1) % 9][2], sacc[(2 * kb + 1) % 9][3]); } else { pw.z = 0u; pw.w = 0u; }
            const bf16x8 pf = __builtin_bit_cast(bf16x8, pw);
            const int key0 = (w + 2 * kb) * 16 + quad * 4, key1 = key0 + 16;
#pragma unroll
            for (int dt = 0; dt < 4; ++dt) {
                const int d = dt * 16 + qi;
                const u32x2 v0 = *(const u32x2*)(VT + d * 264 + key0);
                u32x2 v1 = {0u, 0u};
                if (kb < 4) v1 = *(const u32x2*)(VT + d * 264 + key1);
                const u32x4 vw = {v0.x, v0.y, v1.x, v1.y};
                oacc[dt] = __builtin_amdgcn_mfma_f32_16x16x32_bf16(__builtin_bit_cast(bf16x8, vw), pf, oacc[dt], 0, 0, 0);
            }
        }
        const float inv = 1.0f / lsum;
#pragma unroll
        for (int dt = 0; dt < 4; ++dt) {
            const f32x4 o = oacc[dt] * inv;
            *(f32x4*)(oraw + (size_t)tok * RW + head * 64 + dt * 16 + quad * 4) = o;
            ssq += o[0] * o[0] + o[1] * o[1] + o[2] * o[2] + o[3] * o[3];
        }
    }
    ssq = quad_sum(ssq);
    if (quad == 0) ((float*)(p.ws + WS_SSQA))[(size_t)tok * 4 + kvh] = ssq;
    __syncthreads();
}

__device__ __forceinline__ void st_bf4(unsigned char* q, f32x4 v) { u32x2 w; w.x = cvt_pk_bf16(v[0], v[1]); w.y = cvt_pk_bf16(v[2], v[3]); *(u32x2*)q = w; }
__device__ __forceinline__ f32x4 ld_bf4(const bf16_t* q) { const u32x2 u = *(const u32x2*)q; return (f32x4){bflo(u.x), bfhi(u.x), bflo(u.y), bfhi(u.y)}; }
__device__ __forceinline__ void rwkv_prep_item(const Params& p, const Lt& lt, int l, int item) {
    const int tid = lt.tid, lane = tid & 63, w = __builtin_amdgcn_readfirstlane(tid >> 6), qi = lane & 15, quad = lane >> 4;
    const int t = item * 32 + (w >> 2) * 16 + qi, hg = w & 3;
    const bf16_t* P = (const bf16_t*)(p.ws + WS_P);
    const bf16_t* pt = P + (size_t)t * INC;
    const bf16_t* pp = P + (size_t)(t > 0 ? t - 1 : 0) * INC;
    const float pm = t > 0 ? 1.f : 0.f;
    const float* mu = p.in[3] + l * 2560;
    const bf16_t* lora = (const bf16_t*)(p.ws + WS_LORA + l * SZ_LORA);
    const bf16_t* decT = lora; const bf16_t* aT = lora + 49152; const bf16_t* gT = lora + 98304;
    bf16x8 fw[2], fa[2], fg[4];
#pragma unroll
    for (int ks = 0; ks < 8; ++ks) {
        const int col = COL_XW + ks * 32 + quad * 8;
        const u32x4 c4 = *(const u32x4*)(pt + col), q4 = *(const u32x4*)(pp + col);
        const f32x4 m0 = *(const f32x4*)(mu + col), m1 = *(const f32x4*)(mu + col + 4);
        float v[8];
#pragma unroll
        for (int i = 0; i < 4; ++i) {
            const float c0 = bflo(c4[i]), c1 = bfhi(c4[i]), p0 = bflo(q4[i]) * pm, p1 = bfhi(q4[i]) * pm;
            const float mu0 = (i < 2) ? m0[2 * i] : m1[2 * i - 4], mu1 = (i < 2) ? m0[2 * i + 1] : m1[2 * i - 3];
            v[2 * i] = c0 + (p0 - c0) * mu0; v[2 * i + 1] = c1 + (p1 - c1) * mu1;
        }
        if (ks < 2) {
#pragma unroll
            for (int i = 0; i < 8; ++i) v[i] = tanhf_(v[i]);
        } else if (ks >= 4) {
#pragma unroll
            for (int i = 0; i < 8; ++i) v[i] = sigmoidf_(v[i]);
        }
        u32x4 pk; pk.x = cvt_pk_bf16(v[0], v[1]); pk.y = cvt_pk_bf16(v[2], v[3]); pk.z = cvt_pk_bf16(v[4], v[5]); pk.w = cvt_pk_bf16(v[6], v[7]);
        const bf16x8 f = __builtin_bit_cast(bf16x8, pk);
        if (ks < 2) fw[ks] = f; else if (ks < 4) fa[ks - 2] = f; else fg[ks - 4] = f;
    }
    unsigned char* opnd = p.ws + WS_OPND; float* gate = (float*)(p.ws + WS_GATE); float* bonus = (float*)(p.ws + WS_BONUS);
    const float* w0 = p.in[4] + l * RW; const float* a0 = p.in[6] + l * RW; const float* kkp = p.in[9] + l * RW; const float* kap = p.in[10] + l * RW; const float* rkp = p.in[11] + l * RW;
#pragma unroll
    for (int hh = 0; hh < 3; ++hh) {
        const int h = hg * 3 + hh;
        f32x4 va[4], vkk[4];
        float nrm = 0.f, bon = 0.f;
        unsigned char* ob = opnd + (size_t)t * OPTB + h * OPB;
#pragma unroll
        for (int ct = 0; ct < 4; ++ct) {
            const int crow = h * 64 + ct * 16 + qi;
            f32x4 aw = {0.f, 0.f, 0.f, 0.f}, aa = aw, ag = aw;
#pragma unroll
            for (int ks = 0; ks < 2; ++ks) {
                aw = __builtin_amdgcn_mfma_f32_16x16x32_bf16(*(const bf16x8*)(decT + crow * 64 + ks * 32 + quad * 8), fw[ks], aw, 0, 0, 0);
                aa = __builtin_amdgcn_mfma_f32_16x16x32_bf16(*(const bf16x8*)(aT + crow * 64 + ks * 32 + quad * 8), fa[ks], aa, 0, 0, 0);
            }
#pragma unroll
            for (int ks = 0; ks < 4; ++ks) ag = __builtin_amdgcn_mfma_f32_16x16x32_bf16(*(const bf16x8*)(gT + crow * 128 + ks * 32 + quad * 8), fg[ks], ag, 0, 0, 0);
            const int c = h * 64 + ct * 16 + quad * 4;
            const f32x4 mr = *(const f32x4*)(mu + c), mk = *(const f32x4*)(mu + COL_K + c), mv = *(const f32x4*)(mu + COL_V + c);
            const f32x4 cr = ld_bf4(pt + c), ck = ld_bf4(pt + COL_K + c), cv = ld_bf4(pt + COL_V + c);
            const f32x4 qr = ld_bf4(pp + c) * pm, qk = ld_bf4(pp + COL_K + c) * pm, qv = ld_bf4(pp + COL_V + c) * pm;
            const f32x4 r = cr + (qr - cr) * mr, k = ck + (qk - ck) * mk, v = cv + (qv - cv) * mv;
            const f32x4 w0v = *(const f32x4*)(w0 + c), a0v = *(const f32x4*)(a0 + c), kkv = *(const f32x4*)(kkp + c), kav = *(const f32x4*)(kap + c), rkv = *(const f32x4*)(rkp + c);
            f32x4 dec, a, kk, k2;
#pragma unroll
            for (int j = 0; j < 4; ++j) {
                const float z = -(w0v[j] + aw[j]);
                const float sp = fmaxf(z, 0.f) + __logf(1.0f + __expf(-fabsf(z)));
                dec[j] = __expf(-__expf(-sp - 0.5f));
                a[j] = sigmoidf_(a0v[j] + aa[j]);
                kk[j] = k[j] * kkv[j];
                nrm += kk[j] * kk[j];
                k2[j] = k[j] * (1.0f + (a[j] - 1.0f) * kav[j]);
                bon += r[j] * k2[j] * rkv[j];
            }
            va[ct] = a; vkk[ct] = kk;
            { const int cc = ct * 16 + quad * 4; *(f32x4*)(ob + cc * 4) = dec; st_bf4(ob + 512 + cc * 2, k2); st_bf4(ob + 640 + cc * 2, v); st_bf4(ob + 768 + cc * 2, r); }
            st_bf4((unsigned char*)((bf16_t*)gate + (size_t)t * RW + c), ag);
        }
        nrm = quad_sum(nrm); bon = quad_sum(bon);
        const float inv = rsqrtf(fmaxf(nrm, 1e-24f));
#pragma unroll
        for (int ct = 0; ct < 4; ++ct) {
            const int cc = ct * 16 + quad * 4;
            const f32x4 kkn = vkk[ct] * inv;
            st_bf4(ob + 256 + cc * 2, -kkn);
            st_bf4(ob + 384 + cc * 2, kkn * va[ct]);
        }
        if (quad == 0) bonus[(size_t)t * 16 + h] = bon;
    }
}

__device__ __forceinline__ void gmlp_item(const Params& p, const Lt& lt, int l, int item, unsigned char* lds) {
    const int tid = lt.tid, lane = tid & 63, w = __builtin_amdgcn_readfirstlane(tid >> 6), qi = lane & 15, quad = lane >> 4;
    const bf16_t* P = (const bf16_t*)(p.ws + WS_P);
    bf16_t* ZT = (bf16_t*)lds;
    const int t = item * 128 + w * 16 + qi;
    const bf16_t* pt = P + (size_t)t * INC;
    const float* lng = p.in[16] + l * 512; const float* lnb = p.in[17] + l * 512;
    {
        const bf16_t* src = pt + COL_GZ + quad * 128;
        float s1 = 0.f, s2 = 0.f;
#pragma unroll 4
        for (int e = 0; e < 128; e += 8) {
            const u32x4 u = *(const u32x4*)(src + e);
#pragma unroll
            for (int i = 0; i < 4; ++i) { const float g0 = gelu_exact(bflo(u[i])), g1 = gelu_exact(bfhi(u[i])); s1 += g0 + g1; s2 += g0 * g0 + g1 * g1; }
        }
        s1 = quad_sum(s1); s2 = quad_sum(s2);
        const float mean = s1 * (1.0f / 512), var = fmaxf(s2 * (1.0f / 512) - mean * mean, 0.f), rstd = rsqrtf(var + NORM_EPS);
        const int s = w * 16 + qi;
#pragma unroll 4
        for (int e = 0; e < 128; e += 8) {
            const u32x4 u = *(const u32x4*)(src + e);
#pragma unroll
            for (int i = 0; i < 4; ++i) {
                const int c = quad * 128 + e + 2 * i;
                const float z0 = (gelu_exact(bflo(u[i])) - mean) * rstd * lng[c] + lnb[c], z1 = (gelu_exact(bfhi(u[i])) - mean) * rstd * lng[c + 1] + lnb[c + 1];
                const unsigned pk = cvt_pk_bf16(z0, z1);
                ZT[c * 136 + s] = (bf16_t)(pk & 0xffffu); ZT[(c + 1) * 136 + s] = (bf16_t)(pk >> 16);
            }
        }
    }
    __syncthreads();
    const bf16_t* wsb = (const bf16_t*)(p.ws + WS_LORA + l * SZ_LORA) + 196608;
    const float* bs = p.in[19] + l * 512;
    const int tl = w * 16 + qi, nks = (w >> 1) + 1;
    float ssq = 0.f;
    float* graw = (float*)(p.ws + WS_GRAW) + (size_t)t * 512;
#pragma unroll 1
    for (int h = 0; h < 4; ++h) {
        f32x4 outv[8];
#pragma unroll
        for (int et = 0; et < 8; ++et) outv[et] = (f32x4){0.f, 0.f, 0.f, 0.f};
#pragma unroll 1
        for (int ks = 0; ks < nks; ++ks) {
            const bf16x8 bf = *(const bf16x8*)(wsb + (size_t)(h * 128 + tl) * 128 + ks * 32 + quad * 8);
#pragma unroll
            for (int et = 0; et < 8; ++et) {
                const bf16x8 af = *(const bf16x8*)(ZT + (h * 128 + et * 16 + qi) * 136 + ks * 32 + quad * 8);
                outv[et] = __builtin_amdgcn_mfma_f32_16x16x32_bf16(af, bf, outv[et], 0, 0, 0);
            }
        }
        const float bsv = bs[h * 128 + tl];
#pragma unroll
        for (int et = 0; et < 8; ++et) {
            const f32x4 uu = ld_bf4(pt + COL_GU + h * 128 + et * 16 + quad * 4);
            f32x4 o;
#pragma unroll
            for (int j = 0; j < 4; ++j) { o[j] = gelu_exact(uu[j]) * (outv[et][j] + bsv); ssq += o[j] * o[j]; }
            *(f32x4*)(graw + h * 128 + et * 16 + quad * 4) = o;
        }
    }
    ssq = quad_sum(ssq);
    const float rs = rsqrtf(ssq * (1.0f / 512) + NORM_EPS);
    const float* gng = p.in[20] + l * 512;
    bf16_t* mix = (bf16_t*)(p.ws + WS_MIX) + (size_t)t * DM + 1536;
#pragma unroll 4
    for (int i = 0; i < 32; ++i) {
        const int c = i * 16 + quad * 4;
        const f32x4 g4 = *(const f32x4*)(gng + c);
        const f32x4 o = *(const f32x4*)(graw + c) * rs * g4;
        u32x2 pk; pk.x = cvt_pk_bf16(o[0], o[1]); pk.y = cvt_pk_bf16(o[2], o[3]);
        *(u32x2*)(mix + c) = pk;
    }
    __syncthreads();
}

constexpr int CHMAX = 8;
template <int CTRL> __device__ __forceinline__ float dpp_mov(float v) { return __int_as_float(__builtin_amdgcn_update_dpp(0, __float_as_int(v), CTRL, 0xF, 0xF, true)); }
__device__ __forceinline__ float quad_allsum(float v) { v += dpp_mov<0xB1>(v); v += dpp_mov<0x4E>(v); return v; }
template <int NV, bool WITH_Y, int CH>
__device__ __forceinline__ void scan_run(f32x2 (&S)[4][8], const unsigned char* oh  , LAS float* wl, float* yout  , int lane) {
    const int Lc = lane < 56 ? lane : 55, cch = Lc - 16;
    const bool isw = lane < 16, act = lane < 56;
    const unsigned char* g0 = oh + Lc * 16;
    LAS float* l0 = wl + (isw ? 64 + lane * 4 : ((cch >> 3) == 0 ? 0 : 64 + (cch >> 3) * 64) + (cch & 7) * 8);
    const int cs16 = (lane & 3) * 16, rg4 = (lane >> 2) * 4;
    u32x4 pa[CH];
#pragma unroll
    for (int st = 0; st < CH; ++st) pa[st] = *(const u32x4*)(g0 + (size_t)st * OPTB);
#pragma unroll 1
    for (int c = 0; c < SEGLEN / CH; ++c) {
#pragma unroll
        for (int st = 0; st < CH; ++st) {
            const u32x4 u = pa[st];
            const f32x4 lo = isw ? __builtin_bit_cast(f32x4, u) : (f32x4){bflo(u.x), bfhi(u.x), bflo(u.y), bfhi(u.y)};
            if (act) *(LAS f32x4*)(l0 + st * 384) = lo;
            if (act && !isw) *(LAS f32x4*)(l0 + st * 384 + 4) = (f32x4){bflo(u.z), bfhi(u.z), bflo(u.w), bfhi(u.w)};
        }
        asm volatile("s_waitcnt lgkmcnt(0)" ::: "memory");
        if (c + 1 < SEGLEN / CH) {
            const unsigned char* n0 = g0 + (size_t)(c + 1) * CH * OPTB;
#pragma unroll
            for (int st = 0; st < CH; ++st) pa[st] = *(const u32x4*)(n0 + (size_t)st * OPTB);
        }
#pragma unroll 1
        for (int s = 0; s < CH; ++s) {
            const LAS float* sp = wl + s * 384 + cs16;
            f32x4 a4[4], w4[4], b4[4], k4[4], r4[4], v4 = {0.f, 0.f, 0.f, 0.f};
#pragma unroll
            for (int q = 0; q < 4; ++q) a4[q] = *(const LAS f32x4*)(sp + q * 4);
#pragma unroll
            for (int q = 0; q < 4; ++q) { w4[q] = *(const LAS f32x4*)(sp + 64 + q * 4); b4[q] = *(const LAS f32x4*)(sp + 128 + q * 4); }
            if (NV >= 5) {
#pragma unroll
                for (int q = 0; q < 4; ++q) k4[q] = *(const LAS f32x4*)(sp + 192 + q * 4);
                v4 = *(const LAS f32x4*)(wl + s * 384 + 256 + rg4);
            }
            if (WITH_Y) {
#pragma unroll
                for (int q = 0; q < 4; ++q) r4[q] = *(const LAS f32x4*)(sp + 320 + q * 4);
            }
            __builtin_amdgcn_sched_barrier(0);
            float sa[4];
#pragma unroll
            for (int r = 0; r < 4; ++r) {
                f32x2 e0 = S[r][0] * (f32x2){a4[0][0], a4[0][1]}, e1 = S[r][1] * (f32x2){a4[0][2], a4[0][3]};
#pragma unroll
                for (int q = 1; q < 4; ++q) { e0 += S[r][2 * q] * (f32x2){a4[q][0], a4[q][1]}; e1 += S[r][2 * q + 1] * (f32x2){a4[q][2], a4[q][3]}; }
                sa[r] = quad_allsum((e0[0] + e0[1]) + (e1[0] + e1[1]));
            }
#pragma unroll
            for (int q = 0; q < 4; ++q) {
                const f32x2 wlo = {w4[q][0], w4[q][1]}, whi = {w4[q][2], w4[q][3]}, blo = {b4[q][0], b4[q][1]}, bhi = {b4[q][2], b4[q][3]};
                if (NV >= 5) {
                    const f32x2 klo = {k4[q][0], k4[q][1]}, khi = {k4[q][2], k4[q][3]};
#pragma unroll
                    for (int r = 0; r < 4; ++r) {
                        const f32x2 sa2 = {sa[r], sa[r]}, vi2 = {v4[r], v4[r]};
                        S[r][2 * q] = S[r][2 * q] * wlo + (blo * sa2 + klo * vi2);
                        S[r][2 * q + 1] = S[r][2 * q + 1] * whi + (bhi * sa2 + khi * vi2);
                    }
                } else {
#pragma unroll
                    for (int r = 0; r < 4; ++r) {
                        const f32x2 sa2 = {sa[r], sa[r]};
                        S[r][2 * q] = S[r][2 * q] * wlo + blo * sa2;
                        S[r][2 * q + 1] = S[r][2 * q + 1] * whi + bhi * sa2;
                    }
                }
            }
            if (WITH_Y) {
                float y[4];
#pragma unroll
                for (int r = 0; r < 4; ++r) {
                    f32x2 e0 = S[r][0] * (f32x2){r4[0][0], r4[0][1]}, e1 = S[r][1] * (f32x2){r4[0][2], r4[0][3]};
#pragma unroll
                    for (int q = 1; q < 4; ++q) { e0 += S[r][2 * q] * (f32x2){r4[q][0], r4[q][1]}; e1 += S[r][2 * q + 1] * (f32x2){r4[q][2], r4[q][3]}; }
                    y[r] = quad_allsum((e0[0] + e0[1]) + (e1[0] + e1[1]));
                }
                const int cs = lane & 3;
                const float ysel = cs == 0 ? y[0] : (cs == 1 ? y[1] : (cs == 2 ? y[2] : y[3]));
                yout[(size_t)(c * CH + s) * RW + lane] = ysel;
            }
        }
        asm volatile("s_waitcnt lgkmcnt(0)" ::: "memory");
    }
}

__device__ __forceinline__ void phase_scan1(const Params& p, const Lt& lt, unsigned char* lds) {
    const int tid = lt.tid, w = __builtin_amdgcn_readfirstlane(tid >> 6), G = gridDim.x;
    LAS float* wl = (LAS float*)((LAS unsigned char*)lds) + w * (CHMAX * 384);
    const unsigned char* opnd = p.ws + WS_OPND;
    float* TG = (float*)(p.ws + WS_TG); float* LG = (float*)(p.ws + WS_LG);
    const int nslot = (2 * NH * NSEG + G - 1) / G;
#pragma unroll 1
    for (int j = w; j < nslot; j += 8) {
        int lane = tid & 63; asm volatile("" : "+v"(lane));
        const int kind = (j ^ (j >> 3)) & 1;
        const int rank = j >> 1;
        const int pair = rank * G + lt.bid;
        if (pair >= NH * NSEG) continue;
        const int h = pair / NSEG, g = pair % NSEG, row0 = (lane >> 2) * 4, col0 = (lane & 3) * 16;
        f32x2 S[4][8];
        const unsigned char* oh = opnd + (size_t)g * SEGLEN * OPTB + h * OPB;
        float* dst = (kind == 0 ? TG : LG) + (size_t)(h * NSEG + g) * 4096 + row0 * 64 + col0;
        if (kind == 0) {
#pragma unroll
            for (int r = 0; r < 4; ++r)
#pragma unroll
                for (int q = 0; q < 8; ++q) S[r][q] = (f32x2){(row0 + r == col0 + 2 * q) ? 1.f : 0.f, (row0 + r == col0 + 2 * q + 1) ? 1.f : 0.f};
            scan_run<3, true, 8>(S, oh, wl, (float*)(p.ws + WS_Z) + (size_t)g * SEGLEN * RW + h * 64, lane);
        } else {
#pragma unroll
            for (int r = 0; r < 4; ++r)
#pragma unroll
                for (int q = 0; q < 8; ++q) S[r][q] = (f32x2){0.f, 0.f};
            scan_run<5, true, 8>(S, oh, wl, (float*)(p.ws + WS_YRAW) + (size_t)g * SEGLEN * RW + h * 64, lane);
        }
#pragma unroll
        for (int r = 0; r < 4; ++r)
#pragma unroll
            for (int q = 0; q < 4; ++q) *(f32x4*)(dst + r * 64 + q * 4) = (f32x4){S[r][2 * q][0], S[r][2 * q][1], S[r][2 * q + 1][0], S[r][2 * q + 1][1]};
    }
}
__device__ __forceinline__ void phase_scan2(const Params& p, const Lt& lt, int nblk, unsigned char* lds) {
    const int tid = lt.tid, lane = tid & 63, w = __builtin_amdgcn_readfirstlane(tid >> 6);
    const float* TG = (const float*)(p.ws + WS_TG); const float* LG = (const float*)(p.ws + WS_LG); float* SS = (float*)(p.ws + WS_SS);
    constexpr int D = 6, SLOTF = 4096 + 1024, SP = 66;
    LAS unsigned char* ldsb = (LAS unsigned char*)lds;
    float* Rg = (float*)lds;
    float* Sx = Rg + D * SLOTF;
    const int fi = lane & 15, fq = lane >> 4;
#define CH_WAIT(n) asm volatile("s_waitcnt vmcnt(" #n ")" ::: "memory")
#pragma unroll 1
    for (int it = lt.bid; it < NH * 4; it += nblk) {
        const int h = it >> 2, i0 = (it & 3) * 16;
        const float* Th = TG + (size_t)h * NSEG * 4096 + (size_t)(2 * w) * 256 + lane * 4;
        const float* Lh = LG + (size_t)h * NSEG * 4096 + (size_t)(i0 + 4 * (w & 3)) * 64 + lane * 4;
        float* So = SS + (size_t)h * NSEG * 4096 + (size_t)(i0 + 4 * fq) * 64 + 16 * (w & 3) + fi;
#define CH_DMA(seg, slot) do { const int _sg = (seg) < NSEG - 1 ? (seg) : NSEG - 2; const unsigned _so = (unsigned)(slot) * (SLOTF * 4); \
            __builtin_amdgcn_global_load_lds((const unsigned*)(Th + (size_t)_sg * 4096), (LAS unsigned*)(ldsb + _so + (2 * w) * 1024), 16, 0, 0); \
            __builtin_amdgcn_global_load_lds((const unsigned*)(Th + (size_t)_sg * 4096 + 256), (LAS unsigned*)(ldsb + _so + (2 * w + 1) * 1024), 16, 0, 0); \
            if (w < 4) __builtin_amdgcn_global_load_lds((const unsigned*)(Lh + (size_t)_sg * 4096), (LAS unsigned*)(ldsb + _so + 16384 + w * 1024), 16, 0, 0); } while (0)
        __syncthreads();
        for (int i = tid; i < 2 * 16 * SP; i += NTHREADS) Sx[i] = 0.f;
#pragma unroll
        for (int sgm = 0; sgm < D - 1; ++sgm) CH_DMA(sgm, sgm);
        CH_WAIT(0);
        lds_barrier();
        f32x4 s4 = {0.f, 0.f, 0.f, 0.f};
        int slot = 0;
#pragma unroll 1
        for (int g = 0; g < NSEG; ++g) {
            if (w < 4) CH_WAIT(28); else CH_WAIT(8);
            lds_barrier();
            { const int fs = slot == 0 ? D - 1 : slot - 1; CH_DMA(g + D - 1, fs); }
            if (w < 4) {
#pragma unroll
                for (int r = 0; r < 4; ++r) So[(size_t)g * 4096 + r * 64] = s4[r];
                const float* As = Sx + (g & 1) * 16 * SP + fi * SP + fq;
                const float* Bs = Rg + slot * SLOTF + fq * 64 + 16 * w + fi;
                const float* Lr = Rg + slot * SLOTF + 4096 + (4 * fq) * 64 + 16 * w + fi;
                float av[16], bv[16];
#pragma unroll
                for (int ks = 0; ks < 16; ++ks) { av[ks] = As[4 * ks]; bv[ks] = Bs[(4 * ks) * 64]; }
                f32x4 c0 = {Lr[0], Lr[64], Lr[128], Lr[192]}, c1 = {0.f, 0.f, 0.f, 0.f};
                asm volatile("s_waitcnt lgkmcnt(0)" ::: "memory");
#pragma unroll
                for (int ks = 0; ks < 16; ks += 2) {
                    c0 = __builtin_amdgcn_mfma_f32_16x16x4f32(av[ks], bv[ks], c0, 0, 0, 0);
                    c1 = __builtin_amdgcn_mfma_f32_16x16x4f32(av[ks + 1], bv[ks + 1], c1, 0, 0, 0);
                }
                s4 = c0 + c1;
                float* Sn = Sx + ((g + 1) & 1) * 16 * SP + (4 * fq) * SP + 16 * w + fi;
#pragma unroll
                for (int r = 0; r < 4; ++r) Sn[r * SP] = s4[r];
            }
            slot = slot == D - 1 ? 0 : slot + 1;
        }
        CH_WAIT(0);
    }
#undef CH_DMA
#undef CH_WAIT
}
__device__ __forceinline__ void phase_scan3(const Params& p, const Lt& lt, unsigned char* lds) {
    const int tid = lt.tid, w = __builtin_amdgcn_readfirstlane(tid >> 6);
    const float* SS = (const float*)(p.ws + WS_SS); const float* Z = (const float*)(p.ws + WS_Z); float* yraw = (float*)(p.ws + WS_YRAW);
    const int G = gridDim.x;
#pragma unroll 1
    for (int it = w * G + lt.bid; it < NH * NSEG; it += 8 * G) {
        int lane = tid & 63; asm volatile("" : "+v"(lane));
        const int h = it / NSEG, g = it % NSEG, fi = lane & 15, fq = lane >> 4;
        const float* zb = Z + (size_t)(g * SEGLEN + fi) * RW + h * 64 + fq;
        const float* sb = SS + (size_t)(h * NSEG + g) * 4096 + (size_t)fi * 64 + fq;
        float* yb = yraw + (size_t)(g * SEGLEN + 4 * fq) * RW + h * 64 + fi;
        float bv[4][16];
#pragma unroll
        for (int ti = 0; ti < 4; ++ti)
#pragma unroll
            for (int ks = 0; ks < 16; ++ks) bv[ti][ks] = sb[(size_t)ti * 16 * 64 + 4 * ks];
#pragma unroll 1
        for (int tt = 0; tt < 4; ++tt) {
            float av[16];
#pragma unroll
            for (int ks = 0; ks < 16; ++ks) av[ks] = zb[(size_t)tt * 16 * RW + 4 * ks];
            f32x4 acc[4];
#pragma unroll
            for (int ti = 0; ti < 4; ++ti)
#pragma unroll
                for (int r = 0; r < 4; ++r) acc[ti][r] = yb[(size_t)(tt * 16 + r) * RW + ti * 16];
#pragma unroll
            for (int ks = 0; ks < 16; ++ks)
#pragma unroll
                for (int ti = 0; ti < 4; ++ti) acc[ti] = __builtin_amdgcn_mfma_f32_16x16x4f32(av[ks], bv[ti][ks], acc[ti], 0, 0, 0);
#pragma unroll
            for (int ti = 0; ti < 4; ++ti)
#pragma unroll
                for (int r = 0; r < 4; ++r) yb[(size_t)(tt * 16 + r) * RW + ti * 16] = acc[ti][r];
        }
    }
}

__device__ __forceinline__ void phase_finalize(const Params& p, const Lt& lt, int l) {
    const int tid = lt.tid, lane = tid & 63, w = tid >> 6;
    const float* yraw = (const float*)(p.ws + WS_YRAW); const float* oraw = (const float*)(p.ws + WS_ORAW); const unsigned char* opnd = p.ws + WS_OPND;
    const float* gate = (const float*)(p.ws + WS_GATE); const float* bonus = (const float*)(p.ws + WS_BONUS); const float* ssqa = (const float*)(p.ws + WS_SSQA);
    const float* lg = p.in[12] + l * RW; const float* lb = p.in[13] + l * RW; const float* ang = p.in[15] + l * RW;
    bf16_t* mix = (bf16_t*)(p.ws + WS_MIX);
    for (int t = lt.bid * 8 + w; t < SEQ; t += gridDim.x * 8) {
        const f32x4 sq = *(const f32x4*)(ssqa + (size_t)t * 4);
        const float ra = rsqrtf((sq[0] + sq[1] + sq[2] + sq[3]) * (1.0f / RW) + NORM_EPS);
#pragma unroll
        for (int rnd = 0; rnd < 3; ++rnd) {
            const int c = rnd * 256 + lane * 4, h = c >> 6, cc = c & 63;
            const f32x4 y = *(const f32x4*)(yraw + (size_t)t * RW + c);
            const float m = row16_sum(y[0] + y[1] + y[2] + y[3]) * (1.0f / 64);
            const f32x4 d = y - m;
            const float var = row16_sum(d[0] * d[0] + d[1] * d[1] + d[2] * d[2] + d[3] * d[3]) * (1.0f / 64);
            const float rs = rsqrtf(var + GN_EPS);
            const f32x4 g4 = *(const f32x4*)(lg + c), b4 = *(const f32x4*)(lb + c), v4 = ld_bf4((const bf16_t*)(opnd + (size_t)t * OPTB + h * OPB + 640 + cc * 2)), gt = ld_bf4((const bf16_t*)gate + (size_t)t * RW + c);
            const float bo = bonus[(size_t)t * 16 + h];
            const f32x4 o = (d * rs * g4 + b4 + v4 * bo) * gt;
            u32x2 pk; pk.x = cvt_pk_bf16(o[0], o[1]); pk.y = cvt_pk_bf16(o[2], o[3]);
            *(u32x2*)(mix + (size_t)t * DM + c) = pk;
            const f32x4 oa = *(const f32x4*)(oraw + (size_t)t * RW + c) * ra * *(const f32x4*)(ang + c);
            u32x2 pa; pa.x = cvt_pk_bf16(oa[0], oa[1]); pa.y = cvt_pk_bf16(oa[2], oa[3]);
            *(u32x2*)(mix + (size_t)t * DM + RW + c) = pa;
        }
    }
}

__device__ __forceinline__ void phase_final_norm(const Params& p, const Lt& lt) {
    const int tid = lt.tid, lane = tid & 63, w = tid >> 6;
    const float* x = (const float*)(p.ws + WS_X); const float* ssq = (const float*)(p.ws + WS_SSQ); const float* g = p.in[25];
    for (int t = lt.bid * 8 + w; t < SEQ; t += gridDim.x * 8) {
        const float rs = row_rstd(ssq, t, 1.0f / DM);
#pragma unroll
        for (int i = 0; i < 8; ++i) {
            const int c = i * 256 + lane * 4;
            *(f32x4*)(p.out + (size_t)t * DM + c) = *(const f32x4*)(x + (size_t)t * DM + c) * rs * *(const f32x4*)(g + c);
        }
    }
}

#define XB_TMO      128
#define XB_XCNT(j)  (256  + 64 * (j))
#define XB_XSUB(j)  (1280 + 64 * (j))
#define XB_XGEN(j)  (2304 + 64 * (j))
#define XB_TOP      3328
#define XB_TOPGEN   3392
#define XCD_BAR_WORDS 3456
#define XB_SPIN_CAP (1u << 22)
__device__ __forceinline__ unsigned xb_ld(unsigned* p)              { return __hip_atomic_load(p, __ATOMIC_RELAXED, __HIP_MEMORY_SCOPE_AGENT); }
__device__ __forceinline__ unsigned xb_add(unsigned* p, unsigned v) { return __hip_atomic_fetch_add(p, v, __ATOMIC_RELAXED, __HIP_MEMORY_SCOPE_AGENT); }
__device__ __forceinline__ unsigned xb_xcc_id() { return (unsigned)__builtin_amdgcn_s_getreg((3 << 11) | 20) & 0xFu; }
#define XB_SPIN(cond, bar) do { unsigned _sp = 0; while (cond) { __builtin_amdgcn_s_sleep(1); \
    if ((++_sp & 255u) == 0u) { if (xb_ld(&(bar)[XB_TMO])) break; if (_sp > XB_SPIN_CAP) { atomicAdd(&(bar)[XB_TMO], 1u); break; } } } } while (0)
struct XcdBarrier { unsigned* bar; unsigned x; volatile LAS unsigned* st; };
__device__ __forceinline__ XcdBarrier xcd_barrier_post(unsigned* bar, volatile LAS unsigned* st) {
    XcdBarrier b; b.bar = bar; b.x = xb_xcc_id(); b.st = st;
    if (threadIdx.x == 0) (void)xb_add(&bar[XB_XCNT(b.x)], 1u);
    return b;
}
__device__ __forceinline__ void xcd_barrier_complete(unsigned* bar, unsigned x, unsigned& nloc, unsigned& nx) {
    const unsigned G = gridDim.x * gridDim.y * gridDim.z;
    unsigned sum, cnt, mine, sp = 0u;
    for (;;) {
        sum = 0u; cnt = 0u; mine = 0u;
#pragma unroll
        for (unsigned j = 0; j < 16; ++j) { const unsigned c = xb_ld(&bar[XB_XCNT(j)]); sum += c; cnt += (c > 0u) ? 1u : 0u; mine = (j == x) ? c : mine; }
        if (sum == G) break;
        __builtin_amdgcn_s_sleep(1);
        if ((++sp & 255u) == 0u) { if (xb_ld(&bar[XB_TMO])) break; if (sp > XB_SPIN_CAP) { atomicAdd(&bar[XB_TMO], 1u); break; } }
    }
    nloc = mine > 0u ? mine : 1u; nx = cnt > 0u ? cnt : 1u;
}
__device__ __forceinline__ void xcd_barrier(const XcdBarrier& b) {
    asm volatile("s_waitcnt vmcnt(0)" ::: "memory");
    __syncthreads();
    if (threadIdx.x == 0) {
        unsigned* bar = b.bar;
        __builtin_amdgcn_s_waitcnt(0);
        unsigned nloc = b.st[0], nx = b.st[1];
        if (nloc == 0u) { xcd_barrier_complete(bar, b.x, nloc, nx); b.st[0] = nloc; b.st[1] = nx; }
        const unsigned old = xb_add(&bar[XB_XSUB(b.x)], 1u);
        const unsigned gen = old / nloc;
        if (old + 1u == (gen + 1u) * nloc) {
            __builtin_amdgcn_fence(__ATOMIC_RELEASE, "agent");
            asm volatile("s_waitcnt vmcnt(0)" ::: "memory");
            const unsigned og = xb_add(&bar[XB_TOP], 1u);
            const unsigned tg = og / nx;
            if (og + 1u == (tg + 1u) * nx) xb_add(&bar[XB_TOPGEN], 1u);
            else XB_SPIN(xb_ld(&bar[XB_TOPGEN]) == tg, bar);
            __builtin_amdgcn_fence(__ATOMIC_ACQUIRE, "agent");
            xb_add(&bar[XB_XGEN(b.x)], 1u);
            asm volatile("s_waitcnt vmcnt(0)" ::: "memory");
        } else {
            XB_SPIN(xb_ld(&bar[XB_XGEN(b.x)]) == gen, bar);
            __builtin_amdgcn_fence(__ATOMIC_ACQUIRE, "agent");
            asm volatile("s_waitcnt vmcnt(0)" ::: "memory");
        }
    }
    __syncthreads();
}

constexpr int NPHASE = 2 + 9 * DEPTH;
template <bool COOP>
__global__ void __launch_bounds__(NTHREADS, 2) mega(Params p0) {
    extern __shared__ __attribute__((aligned(16))) unsigned char lds[];
    const int G = gridDim.x;
    XcdBarrier xbar; xbar.bar = nullptr; xbar.x = 0; xbar.st = nullptr;
    if (COOP) {
        volatile LAS unsigned* st = (volatile LAS unsigned*)((LAS unsigned char*)lds + (LDS_BYTES - 16));
        if (threadIdx.x < 4) st[threadIdx.x] = 0u;
        __syncthreads();
        xbar = xcd_barrier_post((unsigned*)(p0.ws + WS_BAR), st);
    }
    for (int ph0 = p0.ph_lo * 2; ph0 < p0.ph_hi * 2; ++ph0) {
        const int ph = ph0 >> 1;
        const int kind = (ph == 0) ? 9 : (ph == NPHASE - 1 ? 10 : (ph - 1) % 9);
        const bool rep = ((MK_REP_MASK >> kind) & 1) != 0;
        if ((ph0 & 1) && !rep) continue;
        Params p = p0; Lt lt; lt.tid = threadIdx.x; lt.bid = blockIdx.x;
        asm volatile("" : "+v"(lt.tid)); asm volatile("" : "+s"(lt.bid));
        { size_t z = 0; asm volatile("" : "+s"(z)); p.ws = p0.ws + z; }
        unsigned char* ws = p.ws;
        if (ph == 0) { if (SEL(0)) phase_prep(p, lt, lds); }
        else if (ph == NPHASE - 1) { if (SEL(1)) phase_final_norm(p, lt); }
        else {
            const int l = (ph - 1) / 9, k = (ph - 1) % 9;
            if (k == 0) { if (SEL(2)) {
                pg8::Gemm g{(const bf16_t*)(ws + WS_XB), (const bf16_t*)(ws + WS_WIN + l * SZ_WIN), SEQ, INC, DM}; pg8::StaticOrder S; S.init(SEQ, INC, G, lt.bid);
                EpiScaleBf16<0> E{(bf16_t*)(ws + WS_P), INC, (const float*)(ws + WS_SSQ)};
                pg8::gemm_phase(lt, (LAS unsigned char*)lds, g, S, E);
                if (G == 256 && lt.bid >= 96 && !(ph0 & 1)) { __syncthreads(); convert_layer(p, lt, l, 864, CONV_TILES, lt.bid - 96, 160, (float*)lds); } }
            } else if (k == 1) {
#pragma unroll 1
                for (int it = lt.bid; it < 256; it += G) {
                    Lt li = lt; asm volatile("" : "+v"(li.tid));
                    if (SEL(4)) rwkv_prep_item(p, li, l, G == 256 ? 2 * (it & 127) + (it >> 7) : it);
                }
            } else if (k == 2) { if (SEL(6)) phase_scan1(p, lt, lds); }
            else if (k == 3) {
                const int nsc = (G >= 192) ? 48 : G;
                if (lt.bid < nsc) { if (SEL(7)) phase_scan2(p, lt, nsc, lds); }
                const int nat = (G >= 192) ? G - 48 : G, b0 = (G >= 192) ? lt.bid - 48 : lt.bid;
                if (b0 >= 0) {
                    if (nat >= 128) {
                        Lt li = lt; asm volatile("" : "+v"(li.tid));
                        if (b0 < 64) { if (SEL(5)) gmlp_item(p, li, l, b0, lds); }
                        else {
#pragma unroll 1
                            for (int it = b0 - 64; it < 256; it += nat - 64) { Lt lj = lt; asm volatile("" : "+v"(lj.tid)); if (SEL(3)) attn_item(p, lj, l, it, lds); }
                        }
                    } else {
#pragma unroll 1
                        for (int it = b0; it < 320; it += nat) {
                            Lt li = lt; asm volatile("" : "+v"(li.tid));
                            if (it < 64) { if (SEL(5)) gmlp_item(p, li, l, it, lds); }
                            else { if (SEL(3)) attn_item(p, li, l, it - 64, lds); }
                        }
                    }
                    if (G == 256 && l + 1 < DEPTH && !(ph0 & 1) && b0 >= 64) convert_layer(p, lt, l + 1, 0, 864, b0 - 64, nat - 64, (float*)lds);
                }
            }
            else if (k == 4) { if (SEL(8)) phase_scan3(p, lt, lds); }
            else if (k == 5) { if (SEL(9)) phase_finalize(p, lt, l); }
            else if (k == 6) { if (SEL(10)) {
                pg8::Gemm g{(const bf16_t*)(ws + WS_MIX), (const bf16_t*)(ws + WS_WOUT + l * SZ_WOUT), SEQ, DM, DM}; pg8::StaticOrder S; S.init(SEQ, DM, G, lt.bid);
                EpiRes E{l == 0 ? p.in[0] : (const float*)(ws + WS_X), (float*)(ws + WS_X), (bf16_t*)(ws + WS_XB), (float*)(ws + WS_SSQ)};
                pg8::gemm_phase(lt, (LAS unsigned char*)lds, g, S, E); }
            } else if (k == 7) { if (SEL(11)) {
                pg8::Gemm g{(const bf16_t*)(ws + WS_XB), (const bf16_t*)(ws + WS_WUP + l * SZ_WUP), SEQ, DFF, DM}; pg8::StaticOrder S; S.init(SEQ, DFF, G, lt.bid);
                EpiScaleBf16<1> E{(bf16_t*)(ws + WS_HB), DFF, (const float*)(ws + WS_SSQ)};
                pg8::gemm_phase(lt, (LAS unsigned char*)lds, g, S, E); }
            } else { if (SEL(12)) {
                pg8::Gemm g{(const bf16_t*)(ws + WS_HB), (const bf16_t*)(ws + WS_WDN + l * SZ_WDN), SEQ, DM, DFF}; pg8::StaticOrder S; S.init(SEQ, DM, G, lt.bid);
                EpiRes E{(const float*)(ws + WS_X), (float*)(ws + WS_X), (bf16_t*)(ws + WS_XB), (float*)(ws + WS_SSQ)};
                pg8::gemm_phase(lt, (LAS unsigned char*)lds, g, S, E); }
            }
        }
        if (COOP) { const bool lastexec = (ph + 1 == p0.ph_hi) && ((ph0 & 1) || !rep); if (!lastexec) { if (p0.ph_hi > NPHASE) cg::this_grid().sync(); else xcd_barrier(xbar); } }
    }
}

extern "C" void kernel_launch(void* const* d_in, const int* in_sizes, int n_in, void* d_out, int out_size, void* d_ws, size_t ws_size, hipStream_t stream) {
    static int grid = 0;
    if (grid == 0) {
        if (n_in != 26 || ws_size < WS_END) { fprintf(stderr, "kernel_launch: unexpected inputs (%d) or workspace (%zu < %zu)\n", n_in, ws_size, (size_t)WS_END); grid = -1; return; }
        int dev = 0, cus = 0, per_cu = 0;
        hipGetDevice(&dev);
        hipDeviceGetAttribute(&cus, hipDeviceAttributeMultiprocessorCount, dev);
        hipFuncSetAttribute((const void*)mega<MK_COOP != 0>, hipFuncAttributeMaxDynamicSharedMemorySize, LDS_BYTES);
        hipOccupancyMaxActiveBlocksPerMultiprocessor(&per_cu, (const void*)mega<MK_COOP != 0>, NTHREADS, LDS_BYTES);
        per_cu = 1;
        grid = cus * per_cu;
        (void)hipGetLastError();
    }
    if (grid < 0) return;
    Params p{};
    for (int i = 0; i < 26; ++i) p.in[i] = (const float*)d_in[i];
    p.out = (float*)d_out; p.ws = (unsigned char*)d_ws;
#if MK_COOP
    p.ph_lo = 0; p.ph_hi = NPHASE;
    (void)hipMemsetAsync((unsigned char*)d_ws + WS_BAR, 0, 16384, stream);
    void* args[] = {&p};
    hipError_t e = hipLaunchCooperativeKernel((const void*)mega<true>, dim3(grid), dim3(NTHREADS), args, LDS_BYTES, stream);
    if (e != hipSuccess) fprintf(stderr, "cooperative launch failed: %s (grid %d)\n", hipGetErrorString(e), grid);
#else
    for (int ph = 0; ph < NPHASE; ++ph) {
        p.ph_lo = ph; p.ph_hi = ph + 1;
        hipLaunchKernelGGL(mega<false>, dim3(grid), dim3(NTHREADS), LDS_BYTES, stream, p);
    }
#endif
}
```

```cpp
#include <hip/hip_runtime.h>
#include <hip/hip_cooperative_groups.h>
#include <cstdio>
namespace cg = cooperative_groups;

#ifndef MK_COOP
#define MK_COOP 1
#endif
#ifndef MK_REP_MASK
#define MK_REP_MASK 0
#endif
#ifndef MK_ONLY
#define MK_ONLY -1
#endif
#define SEL(x) (MK_ONLY < 0 || MK_ONLY == (x))

#define LAS __attribute__((address_space(3)))
typedef unsigned short bf16_t;
typedef short bf16x8 __attribute__((ext_vector_type(8)));
typedef float f32x4 __attribute__((ext_vector_type(4)));
typedef float f32x2 __attribute__((ext_vector_type(2)));
typedef unsigned u32x4 __attribute__((ext_vector_type(4)));
typedef unsigned u32x2 __attribute__((ext_vector_type(2)));

constexpr int SEQ = 8192, DM = 2048, DEPTH = 4, INC = 4864, DFF = 8192;
constexpr int RW = 768, NH = 12;
constexpr int COL_K = 768, COL_V = 1536, COL_XW = 2304, COL_XA = 2368, COL_XG = 2432;
constexpr int COL_AQ = 2560, COL_AK = 3328, COL_AV = 3584, COL_GU = 3840, COL_GZ = 4352;
constexpr float NORM_EPS = 1e-6f, GN_EPS = 64e-5f;
constexpr int SEGLEN = 64, NSEG = SEQ / SEGLEN;
constexpr int OPB = 896, OPTB = NH * OPB;
constexpr int NTHREADS = 512;
constexpr int LDS_BYTES = 147456;

constexpr size_t SZ_WIN = (size_t)INC * DM * 2, SZ_WOUT = (size_t)DM * DM * 2, SZ_WUP = (size_t)DFF * DM * 2, SZ_WDN = (size_t)DM * DFF * 2;
constexpr size_t SZ_LORA = 524288;
constexpr size_t WS_WIN = 0;
constexpr size_t WS_WOUT = WS_WIN + DEPTH * SZ_WIN;
constexpr size_t WS_WUP = WS_WOUT + DEPTH * SZ_WOUT;
constexpr size_t WS_WDN = WS_WUP + DEPTH * SZ_WUP;
constexpr size_t WS_LORA = WS_WDN + DEPTH * SZ_WDN;
constexpr size_t WS_X = WS_LORA + DEPTH * SZ_LORA;
constexpr size_t WS_XB = WS_X + (size_t)SEQ * DM * 4;
constexpr size_t WS_SSQ = WS_XB + (size_t)SEQ * DM * 2;
constexpr size_t WS_MIX = WS_SSQ + (size_t)SEQ * 32 * 4;
constexpr size_t WS_U = WS_MIX + (size_t)SEQ * DM * 2;
constexpr size_t WS_P = WS_U;
constexpr size_t WS_OPND = WS_P + (size_t)SEQ * INC * 2;
constexpr size_t WS_GATE = WS_OPND + (size_t)SEQ * OPTB;
constexpr size_t WS_BONUS = WS_GATE + (size_t)SEQ * RW * 4;
constexpr size_t WS_YRAW = WS_BONUS + (size_t)SEQ * 16 * 4;
constexpr size_t WS_ORAW = WS_YRAW + (size_t)SEQ * RW * 4;
constexpr size_t WS_SSQA = WS_ORAW + (size_t)SEQ * RW * 4;
constexpr size_t WS_TG = WS_SSQA + (size_t)SEQ * 4 * 4;
constexpr size_t WS_LG = WS_TG + (size_t)NH * NSEG * 4096 * 4;
constexpr size_t WS_SS = WS_LG + (size_t)NH * NSEG * 4096 * 4;
constexpr size_t WS_GRAW = WS_SS + (size_t)NH * NSEG * 4096 * 4;
constexpr size_t WS_Z = WS_GRAW + (size_t)SEQ * 512 * 4;
constexpr size_t WS_BAR = WS_Z + (size_t)SEQ * RW * 4;
constexpr size_t WS_END_MIX = WS_BAR + 16384;
constexpr size_t WS_HB = WS_U;
constexpr size_t WS_END = WS_END_MIX;
static_assert(WS_HB + (size_t)SEQ * DFF * 2 <= WS_END, "ffn buffer fits the union");
static_assert(WS_END <= (size_t)1073741824, "workspace budget");

struct Params { const float* in[26]; float* out; unsigned char* ws; int ph_lo, ph_hi; };
struct Lt { int tid, bid; };

typedef __bf16 bf16x2_t __attribute__((ext_vector_type(2)));
__device__ __forceinline__ unsigned cvt_pk_bf16(float lo, float hi) { const f32x2 v = {lo, hi}; return __builtin_bit_cast(unsigned, __builtin_convertvector(v, bf16x2_t)); }
__device__ __forceinline__ float bflo(unsigned u) { return __uint_as_float(u << 16); }
__device__ __forceinline__ float bfhi(unsigned u) { return __uint_as_float(u & 0xffff0000u); }
__device__ __forceinline__ void lds_barrier() { asm volatile("s_waitcnt lgkmcnt(0)" ::: "memory"); __builtin_amdgcn_s_barrier(); asm volatile("" ::: "memory"); }
__device__ __forceinline__ float xor16(float v) { return __shfl_xor(v, 16); }
__device__ __forceinline__ float xor32(float v) { return __shfl_xor(v, 32); }
__device__ __forceinline__ float quad_sum(float v) { v += xor16(v); v += xor32(v); return v; }
__device__ __forceinline__ float row16_sum(float v) { v += __shfl_xor(v, 1); v += __shfl_xor(v, 2); v += __shfl_xor(v, 4); v += __shfl_xor(v, 8); return v; }
__device__ __forceinline__ float gelu_exact(float v) {
    const float av = fabsf(v), t = __builtin_amdgcn_rcpf(av * 0.2316418882f + 1.0f);
    float q = t * 0.5307027145f + (-0.7265760135f); q = q * t + 0.7107068705f; q = q * t + (-0.142248368f); q = q * t + 0.127414796f; q = q * t;
    const float e = __builtin_amdgcn_exp2f((v * v) * (-0.72134752044f));
    const float m = v * (q * e);
    return v < 0.f ? m : v - m;
}
__device__ __forceinline__ float sigmoidf_(float x) { return __builtin_amdgcn_rcpf(1.0f + __expf(-x)); }
__device__ __forceinline__ float tanhf_(float x) { return 1.0f - 2.0f * __builtin_amdgcn_rcpf(1.0f + __expf(2.0f * x)); }
__device__ __forceinline__ float row_rstd(const float* ssq, int row, float inv_n) {
    const f32x4* p = (const f32x4*)(ssq + (size_t)row * 32);
    f32x4 s = p[0];
#pragma unroll
    for (int i = 1; i < 8; ++i) s += p[i];
    return rsqrtf((s[0] + s[1] + s[2] + s[3]) * inv_n + NORM_EPS);
}

namespace pg8 {
constexpr int BM = 256, BK = 64, HALF = 128, HTB = HALF * BK * 2, STAGE_BYTES = 8 * HTB, NXCD = 8, WGM = 8;
__host__ __device__ __forceinline__ int lds_byte(int r, int c) { const int st = (r >> 4) * 2 + (c >> 5), rr = r & 15, cc = c & 31, ob = rr * 64 + cc * 2; return st * 1024 + (ob ^ (((ob >> 9) & 1) << 5)); }
__host__ __device__ __forceinline__ void stage_rc(int b, int& R, int& C) { const int st = b / 1024, sb = b % 1024, swz = sb ^ (((sb >> 9) & 1) << 5); R = (st >> 1) * 16 + swz / 64; C = (st & 1) * 32 + (swz % 64) / 2; }
__host__ __device__ __forceinline__ int perm32(int rho) { const int n = rho >> 4, i = rho & 15; return 8 * (i >> 2) + 4 * n + (i & 3); }
struct Unit { int pm, pn; };
struct Gemm { const bf16_t* A; const bf16_t* Bt; int M, N, K; };
struct StaticOrder {
    int nM, nN, nwg, G, c;
    __device__ void init(int M, int N, int G_, int c_) { nM = M / BM; nN = N / BM; nwg = nM * nN; G = G_; c = c_; }
    __device__ bool next(int i, Unit& u) const {
        const long L = (long)i * G + c; if (L >= nwg) return false;
        int wgid = (int)L; { const int q = nwg / NXCD, r = nwg % NXCD, xcd = wgid % NXCD, off = wgid / NXCD; wgid = (xcd < r ? xcd * (q + 1) : r * (q + 1) + (xcd - r) * q) + off; }
        const int nig = WGM * nN, gid = wgid / nig, fm = gid * WGM, gsz = (nM - fm) < WGM ? (nM - fm) : WGM;
        u.pm = fm + ((wgid % nig) % gsz); u.pn = (wgid % nig) / gsz; return true;
    }
};
template <class Epi>
__device__ __forceinline__ void gemm_phase(const Lt& lt, LAS unsigned char* lds, const Gemm g, const StaticOrder& S, const Epi& E) {
    const int tid = lt.tid, wid = __builtin_amdgcn_readfirstlane(tid >> 6), lane = tid & 63, wr = wid >> 2, wc = wid & 3, fr = lane & 15, fq = lane >> 4;
    const int K = g.K, nt = K / BK;
    unsigned voffA[2], voffB[2];
#pragma unroll
    for (int i = 0; i < 2; ++i) { int R, C; stage_rc(tid * 16 + i * 8192, R, C); const int Rb = (R & ~31) + perm32(R & 31);
        voffA[i] = (unsigned)(R * K + C) * 2u; voffB[i] = (unsigned)(Rb * K + C) * 2u; }
    const size_t kstep = (size_t)(BK * 2);
    const size_t hstep = (size_t)HALF * K * 2;
    const size_t tstep = 2 * hstep;
    const unsigned ldsw = (unsigned)wid * 1024u;
    const int aoff = lds_byte(wr * 64 + fr, fq * 8), boff = lds_byte(wc * 32 + fr, fq * 8);
#define PG8_SA(b, h) (((b) * 2 + (h)) * HTB)
#define PG8_SB(b, h) ((4 + (b) * 2 + (h)) * HTB)
#define PG8_STAGE(bufoff, gbase, voff) do { _Pragma("unroll") for (int _i = 0; _i < 2; ++_i) \
        __builtin_amdgcn_global_load_lds((const unsigned*)((const char*)(gbase) + (voff)[_i]), (LAS unsigned*)(lds + (bufoff) + ldsw + _i * 8192), 16, 0, 0); } while (0)
#define PG8_LDA(dst, b, h) do { _Pragma("unroll") for (int m = 0; m < 4; ++m) _Pragma("unroll") for (int k = 0; k < 2; ++k) dst[m][k] = *(const LAS bf16x8*)(lds + PG8_SA(b, h) + aoff + m * 2048 + k * 1024); } while (0)
#define PG8_LDB(dst, b, h) do { _Pragma("unroll") for (int n = 0; n < 2; ++n) _Pragma("unroll") for (int k = 0; k < 2; ++k) dst[n][k] = *(const LAS bf16x8*)(lds + PG8_SB(b, h) + boff + n * 2048 + k * 1024); } while (0)
#define PG8_MMA(ai, bj, At, Bt) do { __builtin_amdgcn_s_setprio(2); _Pragma("unroll") for (int m = 0; m < 4; ++m) _Pragma("unroll") for (int n = 0; n < 2; ++n) _Pragma("unroll") for (int k = 0; k < 2; ++k) \
        acc[ai][bj][m][n] = __builtin_amdgcn_mfma_f32_16x16x32_bf16(Bt[n][k], At[m][k], acc[ai][bj][m][n], 0, 0, 0); __builtin_amdgcn_s_setprio(0); } while (0)
#define PG8_WAIT_V(n) asm volatile("s_waitcnt vmcnt(" #n ")" ::: "memory")
#define PG8_WAIT_L(n) asm volatile("s_waitcnt lgkmcnt(" #n ")" ::: "memory")
#define PG8_BAR __builtin_amdgcn_s_barrier()
#define PG8_SCHED __builtin_amdgcn_sched_barrier(0)
    Unit cur, nxt; int ui = 0;
    if (!S.next(0, cur)) return;
    { Unit uu; for (int i = 0; i < 8 && S.next(i, uu); ++i) E.prepare(uu, lds, i, tid); }
    f32x4 acc[2][2][4][2];
#pragma unroll
    for (int a = 0; a < 2; ++a)
#pragma unroll
        for (int b = 0; b < 2; ++b)
#pragma unroll
            for (int m = 0; m < 4; ++m)
#pragma unroll
                for (int n = 0; n < 2; ++n) acc[a][b][m][n] = (f32x4){0.f, 0.f, 0.f, 0.f};
    bf16x8 At[4][2], B0[2][2], B1[2][2];
    const char* cA = (const char*)g.A + (size_t)cur.pm * tstep; const char* cB = (const char*)g.Bt + (size_t)cur.pn * tstep;
    PG8_STAGE(PG8_SB(0, 0), cB, voffB); PG8_STAGE(PG8_SB(0, 1), cB + hstep, voffB); PG8_STAGE(PG8_SA(0, 0), cA, voffA); PG8_STAGE(PG8_SA(0, 1), cA + hstep, voffA);
    if (wr == 1) PG8_BAR;
    PG8_WAIT_V(2); PG8_BAR;
    PG8_STAGE(PG8_SB(1, 0), cB + kstep, voffB); PG8_STAGE(PG8_SA(1, 0), cA + kstep, voffA); PG8_STAGE(PG8_SB(1, 1), cB + hstep + kstep, voffB);
    PG8_WAIT_V(6); PG8_BAR;
    for (;;) {
        const bool has_next = S.next(ui + 1, nxt);
        const char* nA = has_next ? (const char*)g.A + (size_t)nxt.pm * tstep : cA; const char* nB = has_next ? (const char*)g.Bt + (size_t)nxt.pn * tstep : cB;
        for (int t = 0; t < nt; t += 2) {
            const bool last = (t == nt - 2);
            const char* a1 = cA + (size_t)(t + 1) * kstep;
            const char* a2 = last ? nA : cA + (size_t)(t + 2) * kstep; const char* b2 = last ? nB : cB + (size_t)(t + 2) * kstep;
            const char* a3 = a2 + kstep; const char* b3 = b2 + kstep;
            PG8_LDB(B0, 0, 0); PG8_LDB(B1, 0, 1); PG8_SCHED; PG8_LDA(At, 0, 0); PG8_STAGE(PG8_SA(1, 1), a1 + hstep, voffA);
            PG8_WAIT_V(8); PG8_WAIT_L(0); PG8_BAR; PG8_MMA(0, 0, At, B0); PG8_MMA(0, 1, At, B1); PG8_BAR; PG8_SCHED;
            PG8_LDA(At, 0, 1); PG8_STAGE(PG8_SB(0, 0), b2, voffB); PG8_STAGE(PG8_SB(0, 1), b2 + hstep, voffB); PG8_STAGE(PG8_SA(0, 0), a2, voffA);
            PG8_WAIT_V(8); PG8_WAIT_L(0); PG8_BAR; PG8_MMA(1, 0, At, B0); PG8_MMA(1, 1, At, B1); PG8_BAR; PG8_SCHED;
            PG8_LDB(B0, 1, 0); PG8_LDB(B1, 1, 1); PG8_SCHED; PG8_LDA(At, 1, 0); PG8_STAGE(PG8_SA(0, 1), a2 + hstep, voffA);
            PG8_WAIT_V(8); PG8_WAIT_L(0); PG8_BAR; PG8_MMA(0, 0, At, B0); PG8_MMA(0, 1, At, B1); PG8_BAR; PG8_SCHED;
            PG8_LDA(At, 1, 1); PG8_STAGE(PG8_SB(1, 0), b3, voffB); PG8_STAGE(PG8_SB(1, 1), b3 + hstep, voffB); PG8_STAGE(PG8_SA(1, 0), a3, voffA);
            PG8_WAIT_V(8); PG8_WAIT_L(0); PG8_BAR; PG8_MMA(1, 0, At, B0); PG8_MMA(1, 1, At, B1); PG8_BAR; PG8_SCHED;
        }
        E(acc, cur, wr, wc, fr, fq, lds, ui & 7);
        if (!has_next) break;
        if (ui + 1 >= 8) E.prepare(nxt, lds, (ui + 1) & 7, tid);
#pragma unroll
        for (int a = 0; a < 2; ++a)
#pragma unroll
            for (int b = 0; b < 2; ++b)
#pragma unroll
                for (int m = 0; m < 4; ++m)
#pragma unroll
                    for (int n = 0; n < 2; ++n) acc[a][b][m][n] = (f32x4){0.f, 0.f, 0.f, 0.f};
        cur = nxt; cA = nA; cB = nB; ++ui;
    }
    PG8_WAIT_V(0);
    if (wr == 0) PG8_BAR;
    PG8_BAR;
#undef PG8_SA
#undef PG8_SB
#undef PG8_STAGE
#undef PG8_LDA
#undef PG8_LDB
#undef PG8_MMA
#undef PG8_WAIT_V
#undef PG8_WAIT_L
#undef PG8_BAR
#undef PG8_SCHED
}
}

template <int ACT> struct EpiScaleBf16 {
    bf16_t* O; int ldc; const float* ssq;
    __device__ __forceinline__ void prepare(const pg8::Unit& u, LAS unsigned char* lds, int buf, int tid) const {
        if (tid < 256) ((LAS float*)(lds + pg8::STAGE_BYTES))[buf * 256 + tid] = row_rstd(ssq, u.pm * 256 + tid, 1.0f / DM);
    }
    __device__ __forceinline__ void operator()(const f32x4 (&acc)[2][2][4][2], const pg8::Unit& u, int wr, int wc, int fr, int fq, LAS unsigned char* lds, int buf) const {
        const int row0 = u.pm * 256 + wr * 64 + fr, col0 = u.pn * 256 + wc * 32 + 8 * fq;
        const LAS float* rst = (const LAS float*)(lds + pg8::STAGE_BYTES) + buf * 256 + wr * 64 + fr;
        float rs[2][4];
#pragma unroll
        for (int ai = 0; ai < 2; ++ai)
#pragma unroll
            for (int m = 0; m < 4; ++m) rs[ai][m] = rst[ai * 128 + m * 16];
#pragma unroll
        for (int ai = 0; ai < 2; ++ai)
#pragma unroll
            for (int m = 0; m < 4; ++m) {
                const int row = row0 + ai * 128 + m * 16;
                bf16_t* rowp = O + (size_t)row * ldc + col0;
#pragma unroll
                for (int bj = 0; bj < 2; ++bj) {
                    f32x4 v0 = acc[ai][bj][m][0] * rs[ai][m], v1 = acc[ai][bj][m][1] * rs[ai][m];
                    if (ACT == 1) {
#pragma unroll
                        for (int j = 0; j < 4; ++j) { const float a = fmaxf(v0[j], 0.f), b = fmaxf(v1[j], 0.f); v0[j] = a * a; v1[j] = b * b; }
                    }
                    u32x4 w; w.x = cvt_pk_bf16(v0[0], v0[1]); w.y = cvt_pk_bf16(v0[2], v0[3]); w.z = cvt_pk_bf16(v1[0], v1[1]); w.w = cvt_pk_bf16(v1[2], v1[3]);
                    *(u32x4*)(rowp + bj * 128) = w;
                }
            }
    }
};
struct EpiRes {
    const float* xsrc; float* xdst; bf16_t* xb; float* ssq;
    __device__ __forceinline__ void prepare(const pg8::Unit&, LAS unsigned char*, int, int) const {}
    __device__ __forceinline__ void operator()(const f32x4 (&acc)[2][2][4][2], const pg8::Unit& u, int wr, int wc, int fr, int fq, LAS unsigned char*, int) const {
        const int row0 = u.pm * 256 + wr * 64 + fr, col0 = u.pn * 256 + wc * 32 + 8 * fq;
        f32x4 xq[2][2][2][2];
#pragma unroll
        for (int mm = 0; mm < 2; ++mm) { const size_t ro = (size_t)(row0 + mm * 16) * DM + col0;
#pragma unroll
            for (int bj = 0; bj < 2; ++bj) { xq[0][mm][bj][0] = *(const f32x4*)(xsrc + ro + bj * 128); xq[0][mm][bj][1] = *(const f32x4*)(xsrc + ro + bj * 128 + 4); } }
#pragma unroll
        for (int q = 0; q < 4; ++q) {
            const int ai = q >> 1, m0 = (q & 1) * 2;
            if (q < 3) {
                const int ain = (q + 1) >> 1, m0n = ((q + 1) & 1) * 2;
#pragma unroll
                for (int mm = 0; mm < 2; ++mm) { const size_t ro = (size_t)(row0 + ain * 128 + (m0n + mm) * 16) * DM + col0;
#pragma unroll
                    for (int bj = 0; bj < 2; ++bj) { xq[(q + 1) & 1][mm][bj][0] = *(const f32x4*)(xsrc + ro + bj * 128); xq[(q + 1) & 1][mm][bj][1] = *(const f32x4*)(xsrc + ro + bj * 128 + 4); } }
            }
#pragma unroll
            for (int mm = 0; mm < 2; ++mm) {
                const int m = m0 + mm, row = row0 + ai * 128 + m * 16;
                const size_t ro = (size_t)row * DM + col0;
                float part = 0.f;
#pragma unroll
                for (int bj = 0; bj < 2; ++bj) {
                    const f32x4 v0 = xq[q & 1][mm][bj][0] + acc[ai][bj][m][0], v1 = xq[q & 1][mm][bj][1] + acc[ai][bj][m][1];
                    *(f32x4*)(xdst + ro + bj * 128) = v0; *(f32x4*)(xdst + ro + bj * 128 + 4) = v1;
                    u32x4 w; w.x = cvt_pk_bf16(v0[0], v0[1]); w.y = cvt_pk_bf16(v0[2], v0[3]); w.z = cvt_pk_bf16(v1[0], v1[1]); w.w = cvt_pk_bf16(v1[2], v1[3]);
                    *(u32x4*)(xb + ro + bj * 128) = w;
#pragma unroll
                    for (int j = 0; j < 4; ++j) part += v0[j] * v0[j] + v1[j] * v1[j];
                }
                part = quad_sum(part);
                if (fq == 0) ssq[(size_t)row * 32 + u.pn * 4 + wc] = part;
            }
        }
    }
};

__device__ __forceinline__ void transpose_job(const Lt& lt, const float* src, bf16_t* dst, const float* scale, int K, int N, int& rot, float* tile  ) {
    const int tid = lt.tid, G = gridDim.x;
    const int tk = K / 64, tn = N / 64, ntile = tk * tn;
    const int first = (int)((lt.bid + G - (rot % G)) % G);
    for (int t = first; t < ntile; t += G) {
        const int k0 = (t / tn) * 64, n0 = (t % tn) * 64;
        { const int kr = tid >> 4, nc = (tid & 15) * 4;
#pragma unroll
          for (int h = 0; h < 2; ++h) { const f32x4 v = *(const f32x4*)(src + (size_t)(k0 + kr + h * 32) * N + n0 + nc);
              float* tp = tile + (kr + h * 32) * 65 + nc; tp[0] = v[0]; tp[1] = v[1]; tp[2] = v[2]; tp[3] = v[3]; } }
        __syncthreads();
        { const int n = tid >> 3, kc = (tid & 7) * 8; float v[8];
#pragma unroll
          for (int i = 0; i < 8; ++i) v[i] = tile[(kc + i) * 65 + n];
          if (scale) {
#pragma unroll
              for (int i = 0; i < 8; ++i) v[i] *= scale[k0 + kc + i]; }
          u32x4 w; w.x = cvt_pk_bf16(v[0], v[1]); w.y = cvt_pk_bf16(v[2], v[3]); w.z = cvt_pk_bf16(v[4], v[5]); w.w = cvt_pk_bf16(v[6], v[7]);
          *(u32x4*)(dst + (size_t)(n0 + n) * K + k0 + kc) = w; }
        __syncthreads();
    }
    rot += ntile;
}

__device__ __forceinline__ void transpose_big(const Lt& lt, const float* src, bf16_t* dst, const float* scale, int K, int N, int tlo, int thi, int phase, int c, int nc, float* tile) {
    const int tid = lt.tid;
    const int tn = N / 128;
    const int first = tlo + (((c - (tlo + phase)) % nc) + nc) % nc;
    const int kr = tid >> 5, nc4 = (tid & 31) * 4;
    const int on = tid & 127, okc = (tid >> 7) * 32;
    f32x4 pre[8];
    if (first < thi) { const int k0 = (first / tn) * 128, n0 = (first % tn) * 128;
#pragma unroll
        for (int h = 0; h < 8; ++h) pre[h] = __builtin_nontemporal_load((const f32x4*)(src + (size_t)(k0 + kr + 16 * h) * N + n0 + nc4)); }
#pragma unroll 1
    for (int t = first; t < thi; t += nc) {
        const int k0 = (t / tn) * 128, n0 = (t % tn) * 128;
#pragma unroll
        for (int h = 0; h < 8; ++h) { float* tp = tile + (kr + 16 * h) * 129 + nc4; tp[0] = pre[h][0]; tp[1] = pre[h][1]; tp[2] = pre[h][2]; tp[3] = pre[h][3]; }
        lds_barrier();
        const int tnx = t + nc;
        if (tnx < thi) { const int k1 = (tnx / tn) * 128, n1 = (tnx % tn) * 128;
#pragma unroll
            for (int h = 0; h < 8; ++h) pre[h] = __builtin_nontemporal_load((const f32x4*)(src + (size_t)(k1 + kr + 16 * h) * N + n1 + nc4)); }
        bf16_t* dp = dst + (size_t)(n0 + on) * K + k0 + okc;
#pragma unroll
        for (int q = 0; q < 4; ++q) {
            float v[8];
#pragma unroll
            for (int i = 0; i < 8; ++i) v[i] = tile[(okc + q * 8 + i) * 129 + on];
            if (scale) {
                const f32x4 s0 = *(const f32x4*)(scale + k0 + okc + q * 8), s1 = *(const f32x4*)(scale + k0 + okc + q * 8 + 4);
#pragma unroll
                for (int i = 0; i < 4; ++i) { v[i] *= s0[i]; v[4 + i] *= s1[i]; }
            }
            u32x4 w; w.x = cvt_pk_bf16(v[0], v[1]); w.y = cvt_pk_bf16(v[2], v[3]); w.z = cvt_pk_bf16(v[4], v[5]); w.w = cvt_pk_bf16(v[6], v[7]);
            *(u32x4*)(dp + q * 8) = w;
        }
        lds_barrier();
    }
}
constexpr int CONV_TILES = 2912;
__device__ __forceinline__ void convert_layer(const Params& p, const Lt& lt, int l, int glo, int ghi, int c, int nc, float* tile) {
    unsigned char* ws = p.ws;
#pragma unroll 1
    for (int m = 0; m < 4; ++m) {
        const int off = m == 0 ? 0 : (m == 1 ? 608 : (m == 2 ? 864 : 1888)), n = m == 0 ? 608 : (m == 1 ? 256 : 1024);
        const int lo = (glo > off ? glo : off) - off, hi = (ghi < off + n ? ghi : off + n) - off;
        if (lo >= hi) continue;
        const float* src = m == 0 ? p.in[2] + (size_t)l * DM * INC : (m == 1 ? p.in[21] + (size_t)l * DM * DM : (m == 2 ? p.in[23] + (size_t)l * DM * DFF : p.in[24] + (size_t)l * DFF * DM));
        bf16_t* dst = (bf16_t*)(m == 0 ? ws + WS_WIN + l * SZ_WIN : (m == 1 ? ws + WS_WOUT + l * SZ_WOUT : (m == 2 ? ws + WS_WUP + l * SZ_WUP : ws + WS_WDN + l * SZ_WDN)));
        const float* scale = m == 0 ? p.in[1] + l * DM : (m == 2 ? p.in[22] + l * DM : nullptr);
        const int K = m == 3 ? DFF : DM, N = m == 0 ? INC : (m == 2 ? DFF : DM);
        transpose_big(lt, src, dst, scale, K, N, lo, hi, off - glo, c, nc, tile);
    }
}

__device__ __forceinline__ void phase_prep(const Params& p, const Lt& lt, unsigned char* lds) {
    float* tile = (float*)lds;
    unsigned char* ws = p.ws;
    int rot = 0;
    if (gridDim.x == 256) convert_layer(p, lt, 0, 0, 864, lt.bid, gridDim.x, tile);
    else for (int l = 0; l < DEPTH; ++l) convert_layer(p, lt, l, 0, CONV_TILES, lt.bid, gridDim.x, tile);
    for (int l = 0; l < DEPTH; ++l) {
        bf16_t* lora = (bf16_t*)(ws + WS_LORA + l * SZ_LORA);
        transpose_job(lt, p.in[5] + (size_t)l * 64 * RW, lora, nullptr, 64, RW, rot, tile);
        transpose_job(lt, p.in[7] + (size_t)l * 64 * RW, lora + 49152, nullptr, 64, RW, rot, tile);
        transpose_job(lt, p.in[8] + (size_t)l * 128 * RW, lora + 98304, nullptr, 128, RW, rot, tile);
    }
    const int gtid = lt.bid * NTHREADS + lt.tid, gsz = gridDim.x * NTHREADS;
    for (int i = gtid; i < DEPTH * 4 * 128 * 128 / 2; i += gsz) {
        const int e = i * 2, l = e >> 16, r = e & 65535, t = (r >> 7) & 127, s = r & 127;
        const float a = p.in[18][e], b = p.in[18][e + 1];
        bf16_t* dst = (bf16_t*)(ws + WS_LORA + l * SZ_LORA) + 196608;
        *(unsigned*)(dst + r) = cvt_pk_bf16(s <= t ? a : 0.f, (s + 1) <= t ? b : 0.f);
    }
    const int wave = gtid >> 6, nwave = gsz >> 6, lane = lt.tid & 63;
    const float* x = p.in[0]; bf16_t* xb = (bf16_t*)(ws + WS_XB); float* ssq = (float*)(ws + WS_SSQ);
    for (int row = wave; row < SEQ; row += nwave) {
        float s = 0.f;
#pragma unroll
        for (int i = 0; i < 4; ++i) {
            const size_t o = (size_t)row * DM + i * 512 + lane * 8;
            const f32x4 a = *(const f32x4*)(x + o), b = *(const f32x4*)(x + o + 4);
            u32x4 w; w.x = cvt_pk_bf16(a[0], a[1]); w.y = cvt_pk_bf16(a[2], a[3]); w.z = cvt_pk_bf16(b[0], b[1]); w.w = cvt_pk_bf16(b[2], b[3]);
            *(u32x4*)(xb + o) = w;
#pragma unroll
            for (int j = 0; j < 4; ++j) s += a[j] * a[j] + b[j] * b[j];
        }
#pragma unroll
        for (int o = 32; o > 0; o >>= 1) s += __shfl_xor(s, o);
        if (lane < 32) ssq[(size_t)row * 32 + lane] = (lane == 0) ? s : 0.f;
    }
}

__device__ __forceinline__ void attn_item(const Params& p, const Lt& lt, int l, int item, unsigned char* lds) {
    const int tid = lt.tid, lane = tid & 63, w = __builtin_amdgcn_readfirstlane(tid >> 6), qi = lane & 15, quad = lane >> 4;
    const int nb = item >> 2, kvh = item & 3;
    const bf16_t* P = (const bf16_t*)(p.ws + WS_P);
    bf16_t* Kl = (bf16_t*)lds;
    bf16_t* VT = (bf16_t*)(lds + 36864);
    for (int u = tid; u < 2048; u += NTHREADS) {
        const int row = u >> 3, part = u & 7, tok = (nb - 1) * 128 + row;
        u32x4 kv = {0u, 0u, 0u, 0u}, vv = {0u, 0u, 0u, 0u};
        if (tok >= 0) { kv = *(const u32x4*)(P + (size_t)tok * INC + COL_AK + kvh * 64 + part * 8); vv = *(const u32x4*)(P + (size_t)tok * INC + COL_AV + kvh * 64 + part * 8); }
        *(u32x4*)(Kl + row * 72 + part * 8) = kv;
#pragma unroll
        for (int i = 0; i < 4; ++i) { VT[(part * 8 + 2 * i) * 264 + row] = (bf16_t)(vv[i] & 0xffffu); VT[(part * 8 + 2 * i + 1) * 264 + row] = (bf16_t)(vv[i] >> 16); }
    }
    __syncthreads();
    const int tok = nb * 128 + w * 16 + qi;
    float* oraw = (float*)(p.ws + WS_ORAW);
    float ssq = 0.f;
    for (int hq = 0; hq < 3; ++hq) {
        const int head = kvh * 3 + hq;
        const float sink = p.in[14][l * 12 + head];
        bf16x8 qf[2];
#pragma unroll
        for (int ks = 0; ks < 2; ++ks) qf[ks] = *(const bf16x8*)(P + (size_t)tok * INC + COL_AQ + head * 64 + ks * 32 + quad * 8);
        f32x4 sacc[9];
        float mx = sink;
#pragma unroll
        for (int rt = 0; rt < 9; ++rt) {
            const int key = (w + rt) * 16 + qi;
            f32x4 a = {0.f, 0.f, 0.f, 0.f};
#pragma unroll
            for (int ks = 0; ks < 2; ++ks) { const bf16x8 kf = *(const bf16x8*)(Kl + key * 72 + ks * 32 + quad * 8); a = __builtin_amdgcn_mfma_f32_16x16x32_bf16(kf, qf[ks], a, 0, 0, 0); }
#pragma unroll
            for (int j = 0; j < 4; ++j) {
                const int jk = (w + rt) * 16 + quad * 4 + j, i = w * 16 + qi;
                const bool valid = (jk > i) && (jk <= i + 128) && (nb > 0 || jk >= 128);
                const float s = valid ? a[j] * 0.125f : -1e30f;
                a[j] = s; mx = fmaxf(mx, s);
            }
            sacc[rt] = a;
        }
        mx = fmaxf(mx, xor16(mx)); mx = fmaxf(mx, xor32(mx));
        float lsum = 0.f;
#pragma unroll
        for (int rt = 0; rt < 9; ++rt)
#pragma unroll
            for (int j = 0; j < 4; ++j) { const float e = __expf(sacc[rt][j] - mx); sacc[rt][j] = e; lsum += e; }
        lsum = quad_sum(lsum) + __expf(sink - mx);
        f32x4 oacc[4];
#pragma unroll
        for (int dt = 0; dt < 4; ++dt) oacc[dt] = (f32x4){0.f, 0.f, 0.f, 0.f};
#pragma unroll
        for (int kb = 0; kb < 5; ++kb) {
            u32x4 pw; pw.x = cvt_pk_bf16(sacc[2 * kb][0], sacc[2 * kb][1]); pw.y = cvt_pk_bf16(sacc[2 * kb][2], sacc[2 * kb][3]);
            if (kb < 4) { pw.z = cvt_pk_bf16(sacc[(2 * kb + 1) % 9][0], sacc[(2 * kb + 1) % 9][1]); pw.w = cvt_pk_bf16(sacc[(2 * kb + 1) % 9][2], sacc[(2 * kb + 1) % 9][3]); } else { pw.z = 0u; pw.w = 0u; }
            const bf16x8 pf = __builtin_bit_cast(bf16x8, pw);
            const int key0 = (w + 2 * kb) * 16 + quad * 4, key1 = key0 + 16;
#pragma unroll
            for (int dt = 0; dt < 4; ++dt) {
                const int d = dt * 16 + qi;
                const u32x2 v0 = *(const u32x2*)(VT + d * 264 + key0);
                u32x2 v1 = {0u, 0u};
                if (kb < 4) v1 = *(const u32x2*)(VT + d * 264 + key1);
                const u32x4 vw = {v0.x, v0.y, v1.x, v1.y};
                oacc[dt] = __builtin_amdgcn_mfma_f32_16x16x32_bf16(__builtin_bit_cast(bf16x8, vw), pf, oacc[dt], 0, 0, 0);
            }
        }
        const float inv = 1.0f / lsum;
#pragma unroll
        for (int dt = 0; dt < 4; ++dt) {
            const f32x4 o = oacc[dt] * inv;
            *(f32x4*)(oraw + (size_t)tok * RW + head * 64 + dt * 16 + quad * 4) = o;
            ssq += o[0] * o[0] + o[1] * o[1] + o[2] * o[2] + o[3] * o[3];
        }
    }
    ssq = quad_sum(ssq);
    if (quad == 0) ((float*)(p.ws + WS_SSQA))[(size_t)tok * 4 + kvh] = ssq;
    __syncthreads();
}

__device__ __forceinline__ void st_bf4(unsigned char* q, f32x4 v) { u32x2 w; w.x = cvt_pk_bf16(v[0], v[1]); w.y = cvt_pk_bf16(v[2], v[3]); *(u32x2*)q = w; }
__device__ __forceinline__ f32x4 ld_bf4(const bf16_t* q) { const u32x2 u = *(const u32x2*)q; return (f32x4){bflo(u.x), bfhi(u.x), bflo(u.y), bfhi(u.y)}; }
__device__ __forceinline__ void rwkv_prep_item(const Params& p, const Lt& lt, int l, int item) {
    const int tid = lt.tid, lane = tid & 63, w = __builtin_amdgcn_readfirstlane(tid >> 6), qi = lane & 15, quad = lane >> 4;
    const int t = item * 32 + (w >> 2) * 16 + qi, hg = w & 3;
    const bf16_t* P = (const bf16_t*)(p.ws + WS_P);
    const bf16_t* pt = P + (size_t)t * INC;
    const bf16_t* pp = P + (size_t)(t > 0 ? t - 1 : 0) * INC;
    const float pm = t > 0 ? 1.f : 0.f;
    const float* mu = p.in[3] + l * 2560;
    const bf16_t* lora = (const bf16_t*)(p.ws + WS_LORA + l * SZ_LORA);
    const bf16_t* decT = lora; const bf16_t* aT = lora + 49152; const bf16_t* gT = lora + 98304;
    bf16x8 fw[2], fa[2], fg[4];
#pragma unroll
    for (int ks = 0; ks < 8; ++ks) {
        const int col = COL_XW + ks * 32 + quad * 8;
        const u32x4 c4 = *(const u32x4*)(pt + col), q4 = *(const u32x4*)(pp + col);
        const f32x4 m0 = *(const f32x4*)(mu + col), m1 = *(const f32x4*)(mu + col + 4);
        float v[8];
#pragma unroll
        for (int i = 0; i < 4; ++i) {
            const float c0 = bflo(c4[i]), c1 = bfhi(c4[i]), p0 = bflo(q4[i]) * pm, p1 = bfhi(q4[i]) * pm;
            const float mu0 = (i < 2) ? m0[2 * i] : m1[2 * i - 4], mu1 = (i < 2) ? m0[2 * i + 1] : m1[2 * i - 3];
            v[2 * i] = c0 + (p0 - c0) * mu0; v[2 * i + 1] = c1 + (p1 - c1) * mu1;
        }
        if (ks < 2) {
#pragma unroll
            for (int i = 0; i < 8; ++i) v[i] = tanhf_(v[i]);
        } else if (ks >= 4) {
#pragma unroll
            for (int i = 0; i < 8; ++i) v[i] = sigmoidf_(v[i]);
        }
        u32x4 pk; pk.x = cvt_pk_bf16(v[0], v[1]); pk.y = cvt_pk_bf16(v[2], v[3]); pk.z = cvt_pk_bf16(v[4], v[5]); pk.w = cvt_pk_bf16(v[6], v[7]);
        const bf16x8 f = __builtin_bit_cast(bf16x8, pk);
        if (ks < 2) fw[ks] = f; else if (ks < 4) fa[ks - 2] = f; else fg[ks - 4] = f;
    }
    unsigned char* opnd = p.ws + WS_OPND; float* gate = (float*)(p.ws + WS_GATE); float* bonus = (float*)(p.ws + WS_BONUS);
    const float* w0 = p.in[4] + l * RW; const float* a0 = p.in[6] + l * RW; const float* kkp = p.in[9] + l * RW; const float* kap = p.in[10] + l * RW; const float* rkp = p.in[11] + l * RW;
#pragma unroll
    for (int hh = 0; hh < 3; ++hh) {
        const int h = hg * 3 + hh;
        f32x4 va[4], vkk[4];
        float nrm = 0.f, bon = 0.f;
        unsigned char* ob = opnd + (size_t)t * OPTB + h * OPB;
#pragma unroll
        for (int ct = 0; ct < 4; ++ct) {
            const int crow = h * 64 + ct * 16 + qi;
            f32x4 aw = {0.f, 0.f, 0.f, 0.f}, aa = aw, ag = aw;
#pragma unroll
            for (int ks = 0; ks < 2; ++ks) {
                aw = __builtin_amdgcn_mfma_f32_16x16x32_bf16(*(const bf16x8*)(decT + crow * 64 + ks * 32 + quad * 8), fw[ks], aw, 0, 0, 0);
                aa = __builtin_amdgcn_mfma_f32_16x16x32_bf16(*(const bf16x8*)(aT + crow * 64 + ks * 32 + quad * 8), fa[ks], aa, 0, 0, 0);
            }
#pragma unroll
            for (int ks = 0; ks < 4; ++ks) ag = __builtin_amdgcn_mfma_f32_16x16x32_bf16(*(const bf16x8*)(gT + crow * 128 + ks * 32 + quad * 8), fg[ks], ag, 0, 0, 0);
            const int c = h * 64 + ct * 16 + quad * 4;
            const f32x4 mr = *(const f32x4*)(mu + c), mk = *(const f32x4*)(mu + COL_K + c), mv = *(const f32x4*)(mu + COL_V + c);
            const f32x4 cr = ld_bf4(pt + c), ck = ld_bf4(pt + COL_K + c), cv = ld_bf4(pt + COL_V + c);
            const f32x4 qr = ld_bf4(pp + c) * pm, qk = ld_bf4(pp + COL_K + c) * pm, qv = ld_bf4(pp + COL_V + c) * pm;
            const f32x4 r = cr + (qr - cr) * mr, k = ck + (qk - ck) * mk, v = cv + (qv - cv) * mv;
            const f32x4 w0v = *(const f32x4*)(w0 + c), a0v = *(const f32x4*)(a0 + c), kkv = *(const f32x4*)(kkp + c), kav = *(const f32x4*)(kap + c), rkv = *(const f32x4*)(rkp + c);
            f32x4 dec, a, kk, k2;
#pragma unroll
            for (int j = 0; j < 4; ++j) {
                const float z = -(w0v[j] + aw[j]);
                const float sp = fmaxf(z, 0.f) + __logf(1.0f + __expf(-fabsf(z)));
                dec[j] = __expf(-__expf(-sp - 0.5f));
                a[j] = sigmoidf_(a0v[j] + aa[j]);
                kk[j] = k[j] * kkv[j];
                nrm += kk[j] * kk[j];
                k2[j] = k[j] * (1.0f + (a[j] - 1.0f) * kav[j]);
                bon += r[j] * k2[j] * rkv[j];
            }
            va[ct] = a; vkk[ct] = kk;
            { const int cc = ct * 16 + quad * 4; *(f32x4*)(ob + cc * 4) = dec; st_bf4(ob + 512 + cc * 2, k2); st_bf4(ob + 640 + cc * 2, v); st_bf4(ob + 768 + cc * 2, r); }
            st_bf4((unsigned char*)((bf16_t*)gate + (size_t)t * RW + c), ag);
        }
        nrm = quad_sum(nrm); bon = quad_sum(bon);
        const float inv = rsqrtf(fmaxf(nrm, 1e-24f));
#pragma unroll
        for (int ct = 0; ct < 4; ++ct) {
            const int cc = ct * 16 + quad * 4;
            const f32x4 kkn = vkk[ct] * inv;
            st_bf4(ob + 256 + cc * 2, -kkn);
            st_bf4(ob + 384 + cc * 2, kkn * va[ct]);
        }
        if (quad == 0) bonus[(size_t)t * 16 + h] = bon;
    }
}

__device__ __forceinline__ void gmlp_item(const Params& p, const Lt& lt, int l, int item, unsigned char* lds) {
    const int tid = lt.tid, lane = tid & 63, w = __builtin_amdgcn_readfirstlane(tid >> 6), qi = lane & 15, quad = lane >> 4;
    const bf16_t* P = (const bf16_t*)(p.ws + WS_P);
    bf16_t* ZT = (bf16_t*)lds;
    const int t = item * 128 + w * 16 + qi;
    const bf16_t* pt = P + (size_t)t * INC;
    const float* lng = p.in[16] + l * 512; const float* lnb = p.in[17] + l * 512;
    {
        const bf16_t* src = pt + COL_GZ + quad * 128;
        float s1 = 0.f, s2 = 0.f;
#pragma unroll 4
        for (int e = 0; e < 128; e += 8) {
            const u32x4 u = *(const u32x4*)(src + e);
#pragma unroll
            for (int i = 0; i < 4; ++i) { const float g0 = gelu_exact(bflo(u[i])), g1 = gelu_exact(bfhi(u[i])); s1 += g0 + g1; s2 += g0 * g0 + g1 * g1; }
        }
        s1 = quad_sum(s1); s2 = quad_sum(s2);
        const float mean = s1 * (1.0f / 512), var = fmaxf(s2 * (1.0f / 512) - mean * mean, 0.f), rstd = rsqrtf(var + NORM_EPS);
        const int s = w * 16 + qi;
#pragma unroll 4
        for (int e = 0; e < 128; e += 8) {
            const u32x4 u = *(const u32x4*)(src + e);
#pragma unroll
            for (int i = 0; i < 4; ++i) {
                const int c = quad * 128 + e + 2 * i;
                const float z0 = (gelu_exact(bflo(u[i])) - mean) * rstd * lng[c] + lnb[c], z1 = (gelu_exact(bfhi(u[i])) - mean) * rstd * lng[c + 1] + lnb[c + 1];
                const unsigned pk = cvt_pk_bf16(z0, z1);
                ZT[c * 136 + s] = (bf16_t)(pk & 0xffffu); ZT[(c + 1) * 136 + s] = (bf16_t)(pk >> 16);
            }
        }
    }
    __syncthreads();
    const bf16_t* wsb = (const bf16_t*)(p.ws + WS_LORA + l * SZ_LORA) + 196608;
    const float* bs = p.in[19] + l * 512;
    const int tl = w * 16 + qi, nks = (w >> 1) + 1;
    float ssq = 0.f;
    float* graw = (float*)(p.ws + WS_GRAW) + (size_t)t * 512;
#pragma unroll 1
    for (int h = 0; h < 4; ++h) {
        f32x4 outv[8];
#pragma unroll
        for (int et = 0; et < 8; ++et) outv[et] = (f32x4){0.f, 0.f, 0.f, 0.f};
#pragma unroll 1
        for (int ks = 0; ks < nks; ++ks) {
            const bf16x8 bf = *(const bf16x8*)(wsb + (size_t)(h * 128 + tl) * 128 + ks * 32 + quad * 8);
#pragma unroll
            for (int et = 0; et < 8; ++et) {
                const bf16x8 af = *(const bf16x8*)(ZT + (h * 128 + et * 16 + qi) * 136 + ks * 32 + quad * 8);
                outv[et] = __builtin_amdgcn_mfma_f32_16x16x32_bf16(af, bf, outv[et], 0, 0, 0);
            }
        }
        const float bsv = bs[h * 128 + tl];
#pragma unroll
        for (int et = 0; et < 8; ++et) {
            const f32x4 uu = ld_bf4(pt + COL_GU + h * 128 + et * 16 + quad * 4);
            f32x4 o;
#pragma unroll
            for (int j = 0; j < 4; ++j) { o[j] = gelu_exact(uu[j]) * (outv[et][j] + bsv); ssq += o[j] * o[j]; }
            *(f32x4*)(graw + h * 128 + et * 16 + quad * 4) = o;
        }
    }
    ssq = quad_sum(ssq);
    const float rs = rsqrtf(ssq * (1.0f / 512) + NORM_EPS);
    const float* gng = p.in[20] + l * 512;
    bf16_t* mix = (bf16_t*)(p.ws + WS_MIX) + (size_t)t * DM + 1536;
#pragma unroll 4
    for (int i = 0; i < 32; ++i) {
        const int c = i * 16 + quad * 4;
        const f32x4 g4 = *(const f32x4*)(gng + c);
        const f32x4 o = *(const f32x4*)(graw + c) * rs * g4;
        u32x2 pk; pk.x = cvt_pk_bf16(o[0], o[1]); pk.y = cvt_pk_bf16(o[2], o[3]);
        *(u32x2*)(mix + c) = pk;
    }
    __syncthreads();
}

constexpr int CHMAX = 8;
template <int CTRL> __device__ __forceinline__ float dpp_mov(float v) { return __int_as_float(__builtin_amdgcn_update_dpp(0, __float_as_int(v), CTRL, 0xF, 0xF, true)); }
__device__ __forceinline__ float quad_allsum(float v) { v += dpp_mov<0xB1>(v); v += dpp_mov<0x4E>(v); return v; }
template <int NV, bool WITH_Y, int CH>
__device__ __forceinline__ void scan_run(f32x2 (&S)[4][8], const unsigned char* oh  , LAS float* wl, float* yout  , int lane) {
    const int Lc = lane < 56 ? lane : 55, cch = Lc - 16;
    const bool isw = lane < 16, act = lane < 56;
    const unsigned char* g0 = oh + Lc * 16;
    LAS float* l0 = wl + (isw ? 64 + lane * 4 : ((cch >> 3) == 0 ? 0 : 64 + (cch >> 3) * 64) + (cch & 7) * 8);
    const int cs16 = (lane & 3) * 16, rg4 = (lane >> 2) * 4;
    u32x4 pa[CH];
#pragma unroll
    for (int st = 0; st < CH; ++st) pa[st] = *(const u32x4*)(g0 + (size_t)st * OPTB);
#pragma unroll 1
    for (int c = 0; c < SEGLEN / CH; ++c) {
#pragma unroll
        for (int st = 0; st < CH; ++st) {
            const u32x4 u = pa[st];
            const f32x4 lo = isw ? __builtin_bit_cast(f32x4, u) : (f32x4){bflo(u.x), bfhi(u.x), bflo(u.y), bfhi(u.y)};
            if (act) *(LAS f32x4*)(l0 + st * 384) = lo;
            if (act && !isw) *(LAS f32x4*)(l0 + st * 384 + 4) = (f32x4){bflo(u.z), bfhi(u.z), bflo(u.w), bfhi(u.w)};
        }
        asm volatile("s_waitcnt lgkmcnt(0)" ::: "memory");
        if (c + 1 < SEGLEN / CH) {
            const unsigned char* n0 = g0 + (size_t)(c + 1) * CH * OPTB;
#pragma unroll
            for (int st = 0; st < CH; ++st) pa[st] = *(const u32x4*)(n0 + (size_t)st * OPTB);
        }
#pragma unroll 1
        for (int s = 0; s < CH; ++s) {
            const LAS float* sp = wl + s * 384 + cs16;
            f32x4 a4[4], w4[4], b4[4], k4[4], r4[4], v4 = {0.f, 0.f, 0.f, 0.f};
#pragma unroll
            for (int q = 0; q < 4; ++q) a4[q] = *(const LAS f32x4*)(sp + q * 4);
#pragma unroll
            for (int q = 0; q < 4; ++q) { w4[q] = *(const LAS f32x4*)(sp + 64 + q * 4); b4[q] = *(const LAS f32x4*)(sp + 128 + q * 4); }
            if (NV >= 5) {
#pragma unroll
                for (int q = 0; q < 4; ++q) k4[q] = *(const LAS f32x4*)(sp + 192 + q * 4);
                v4 = *(const LAS f32x4*)(wl + s * 384 + 256 + rg4);
            }
            if (WITH_Y) {
#pragma unroll
                for (int q = 0; q < 4; ++q) r4[q] = *(const LAS f32x4*)(sp + 320 + q * 4);
            }
            __builtin_amdgcn_sched_barrier(0);
            float sa[4];
#pragma unroll
            for (int r = 0; r < 4; ++r) {
                f32x2 e0 = S[r][0] * (f32x2){a4[0][0], a4[0][1]}, e1 = S[r][1] * (f32x2){a4[0][2], a4[0][3]};
#pragma unroll
                for (int q = 1; q < 4; ++q) { e0 += S[r][2 * q] * (f32x2){a4[q][0], a4[q][1]}; e1 += S[r][2 * q + 1] * (f32x2){a4[q][2], a4[q][3]}; }
                sa[r] = quad_allsum((e0[0] + e0[1]) + (e1[0] + e1[1]));
            }
#pragma unroll
            for (int q = 0; q < 4; ++q) {
                const f32x2 wlo = {w4[q][0], w4[q][1]}, whi = {w4[q][2], w4[q][3]}, blo = {b4[q][0], b4[q][1]}, bhi = {b4[q][2], b4[q][3]};
                if (NV >= 5) {
                    const f32x2 klo = {k4[q][0], k4[q][1]}, khi = {k4[q][2], k4[q][3]};
#pragma unroll
                    for (int r = 0; r < 4; ++r) {
                        const f32x2 sa2 = {sa[r], sa[r]}, vi2 = {v4[r], v4[r]};
                        S[r][2 * q] = S[r][2 * q] * wlo + (blo * sa2 + klo * vi2);
                        S[r][2 * q + 1] = S[r][2 * q + 1] * whi + (bhi * sa2 + khi * vi2);
                    }
                } else {
#pragma unroll
                    for (int r = 0; r < 4; ++r) {
                        const f32x2 sa2 = {sa[r], sa[r]};
                        S[r][2 * q] = S[r][2 * q] * wlo + blo * sa2;
                        S[r][2 * q + 1] = S[r][2 * q + 1] * whi + bhi * sa2;
                    }
                }
            }
            if (WITH_Y) {
                float y[4];
#pragma unroll
                for (int r = 0; r < 4; ++r) {
                    f32x2 e0 = S[r][0] * (f32x2){r4[0][0], r4[0][1]}, e1 = S[r][1] * (f32x2){r4[0][2], r4[0][3]};
#pragma unroll
                    for (int q = 1; q < 4; ++q) { e0 += S[r][2 * q] * (f32x2){r4[q][0], r4[q][1]}; e1 += S[r][2 * q + 1] * (f32x2){r4[q][2], r4[q][3]}; }
                    y[r] = quad_allsum((e0[0] + e0[1]) + (e1[0] + e1[1]));
                }
                const int cs = lane & 3;
                const float ysel = cs == 0 ? y[0] : (cs == 1 ? y[1] : (cs == 2 ? y[2] : y[3]));
                yout[(size_t)(c * CH + s) * RW + lane] = ysel;
            }
        }
        asm volatile("s_waitcnt lgkmcnt(0)" ::: "memory");
    }
}

__device__ __forceinline__ void phase_scan1(const Params& p, const Lt& lt, unsigned char* lds) {
    const int tid = lt.tid, w = __builtin_amdgcn_readfirstlane(tid >> 6), G = gridDim.x;
    LAS float* wl = (LAS float*)((LAS unsigned char*)lds) + w * (CHMAX * 384);
    const unsigned char* opnd = p.ws + WS_OPND;
    float* TG = (float*)(p.ws + WS_TG); float* LG = (float*)(p.ws + WS_LG);
    const int nslot = (2 * NH * NSEG + G - 1) / G;
#pragma unroll 1
    for (int j = w; j < nslot; j += 8) {
        int lane = tid & 63; asm volatile("" : "+v"(lane));
        const int kind = (j ^ (j >> 3)) & 1;
        const int rank = j >> 1;
        const int pair = rank * G + lt.bid;
        if (pair >= NH * NSEG) continue;
        const int h = pair / NSEG, g = pair % NSEG, row0 = (lane >> 2) * 4, col0 = (lane & 3) * 16;
        f32x2 S[4][8];
        const unsigned char* oh = opnd + (size_t)g * SEGLEN * OPTB + h * OPB;
        float* dst = (kind == 0 ? TG : LG) + (size_t)(h * NSEG + g) * 4096 + row0 * 64 + col0;
        if (kind == 0) {
#pragma unroll
            for (int r = 0; r < 4; ++r)
#pragma unroll
                for (int q = 0; q < 8; ++q) S[r][q] = (f32x2){(row0 + r == col0 + 2 * q) ? 1.f : 0.f, (row0 + r == col0 + 2 * q + 1) ? 1.f : 0.f};
            scan_run<3, true, 8>(S, oh, wl, (float*)(p.ws + WS_Z) + (size_t)g * SEGLEN * RW + h * 64, lane);
        } else {
#pragma unroll
            for (int r = 0; r < 4; ++r)
#pragma unroll
                for (int q = 0; q < 8; ++q) S[r][q] = (f32x2){0.f, 0.f};
            scan_run<5, true, 8>(S, oh, wl, (float*)(p.ws + WS_YRAW) + (size_t)g * SEGLEN * RW + h * 64, lane);
        }
#pragma unroll
        for (int r = 0; r < 4; ++r)
#pragma unroll
            for (int q = 0; q < 4; ++q) *(f32x4*)(dst + r * 64 + q * 4) = (f32x4){S[r][2 * q][0], S[r][2 * q][1], S[r][2 * q + 1][0], S[r][2 * q + 1][1]};
    }
}
__device__ __forceinline__ void phase_scan2(const Params& p, const Lt& lt, int nblk, unsigned char* lds) {
    const int tid = lt.tid, lane = tid & 63, w = __builtin_amdgcn_readfirstlane(tid >> 6);
    const float* TG = (const float*)(p.ws + WS_TG); const float* LG = (const float*)(p.ws + WS_LG); float* SS = (float*)(p.ws + WS_SS);
    constexpr int D = 6, SLOTF = 4096 + 1024, SP = 66;
    LAS unsigned char* ldsb = (LAS unsigned char*)lds;
    float* Rg = (float*)lds;
    float* Sx = Rg + D * SLOTF;
    const int fi = lane & 15, fq = lane >> 4;
#define CH_WAIT(n) asm volatile("s_waitcnt vmcnt(" #n ")" ::: "memory")
#pragma unroll 1
    for (int it = lt.bid; it < NH * 4; it += nblk) {
        const int h = it >> 2, i0 = (it & 3) * 16;
        const float* Th = TG + (size_t)h * NSEG * 4096 + (size_t)(2 * w) * 256 + lane * 4;
        const float* Lh = LG + (size_t)h * NSEG * 4096 + (size_t)(i0 + 4 * (w & 3)) * 64 + lane * 4;
        float* So = SS + (size_t)h * NSEG * 4096 + (size_t)(i0 + 4 * fq) * 64 + 16 * (w & 3) + fi;
#define CH_DMA(seg, slot) do { const int _sg = (seg) < NSEG - 1 ? (seg) : NSEG - 2; const unsigned _so = (unsigned)(slot) * (SLOTF * 4); \
            __builtin_amdgcn_global_load_lds((const unsigned*)(Th + (size_t)_sg * 4096), (LAS unsigned*)(ldsb + _so + (2 * w) * 1024), 16, 0, 0); \
            __builtin_amdgcn_global_load_lds((const unsigned*)(Th + (size_t)_sg * 4096 + 256), (LAS unsigned*)(ldsb + _so + (2 * w + 1) * 1024), 16, 0, 0); \
            if (w < 4) __builtin_amdgcn_global_load_lds((const unsigned*)(Lh + (size_t)_sg * 4096), (LAS unsigned*)(ldsb + _so + 16384 + w * 1024), 16, 0, 0); } while (0)
        __syncthreads();
        for (int i = tid; i < 2 * 16 * SP; i += NTHREADS) Sx[i] = 0.f;
#pragma unroll
        for (int sgm = 0; sgm < D - 1; ++sgm) CH_DMA(sgm, sgm);
        CH_WAIT(0);
        lds_barrier();
        f32x4 s4 = {0.f, 0.f, 0.f, 0.f};
        int slot = 0;
#pragma unroll 1
        for (int g = 0; g < NSEG; ++g) {
            if (w < 4) CH_WAIT(28); else CH_WAIT(8);
            lds_barrier();
            { const int fs = slot == 0 ? D - 1 : slot - 1; CH_DMA(g + D - 1, fs); }
            if (w < 4) {
#pragma unroll
                for (int r = 0; r < 4; ++r) So[(size_t)g * 4096 + r * 64] = s4[r];
                const float* As = Sx + (g & 1) * 16 * SP + fi * SP + fq;
                const float* Bs = Rg + slot * SLOTF + fq * 64 + 16 * w + fi;
                const float* Lr = Rg + slot * SLOTF + 4096 + (4 * fq) * 64 + 16 * w + fi;
                float av[16], bv[16];
#pragma unroll
                for (int ks = 0; ks < 16; ++ks) { av[ks] = As[4 * ks]; bv[ks] = Bs[(4 * ks) * 64]; }
                f32x4 c0 = {Lr[0], Lr[64], Lr[128], Lr[192]}, c1 = {0.f, 0.f, 0.f, 0.f};
                asm volatile("s_waitcnt lgkmcnt(0)" ::: "memory");
#pragma unroll
                for (int ks = 0; ks < 16; ks += 2) {
                    c0 = __builtin_amdgcn_mfma_f32_16x16x4f32(av[ks], bv[ks], c0, 0, 0, 0);
                    c1 = __builtin_amdgcn_mfma_f32_16x16x4f32(av[ks + 1], bv[ks + 1], c1, 0, 0, 0);
                }
                s4 = c0 + c1;
                float* Sn = Sx + ((g + 1) & 1) * 16 * SP + (4 * fq) * SP + 16 * w + fi;
#pragma unroll
                for (int r = 0; r < 4; ++r) Sn[r * SP] = s4[r];
            }
            slot = slot == D - 1 ? 0 : slot + 1;
        }
        CH_WAIT(0);
    }
#undef CH_DMA
#undef CH_WAIT
}
__device__ __forceinline__ void phase_scan3(const Params& p, const Lt& lt, unsigned char* lds) {
    const int tid = lt.tid, w = __builtin_amdgcn_readfirstlane(tid >> 6);
    const float* SS = (const float*)(p.ws + WS_SS); const float* Z = (const float*)(p.ws + WS_Z); float* yraw = (float*)(p.ws + WS_YRAW);
    const int G = gridDim.x;
#pragma unroll 1
    for (int it = w * G + lt.bid; it < NH * NSEG; it += 8 * G) {
        int lane = tid & 63; asm volatile("" : "+v"(lane));
        const int h = it / NSEG, g = it % NSEG, fi = lane & 15, fq = lane >> 4;
        const float* zb = Z + (size_t)(g * SEGLEN + fi) * RW + h * 64 + fq;
        const float* sb = SS + (size_t)(h * NSEG + g) * 4096 + (size_t)fi * 64 + fq;
        float* yb = yraw + (size_t)(g * SEGLEN + 4 * fq) * RW + h * 64 + fi;
        float bv[4][16];
#pragma unroll
        for (int ti = 0; ti < 4; ++ti)
#pragma unroll
            for (int ks = 0; ks < 16; ++ks) bv[ti][ks] = sb[(size_t)ti * 16 * 64 + 4 * ks];
#pragma unroll 1
        for (int tt = 0; tt < 4; ++tt) {
            float av[16];
#pragma unroll
            for (int ks = 0; ks < 16; ++ks) av[ks] = zb[(size_t)tt * 16 * RW + 4 * ks];
            f32x4 acc[4];
#pragma unroll
            for (int ti = 0; ti < 4; ++ti)
#pragma unroll
                for (int r = 0; r < 4; ++r) acc[ti][r] = yb[(size_t)(tt * 16 + r) * RW + ti * 16];
#pragma unroll
            for (int ks = 0; ks < 16; ++ks)
#pragma unroll
                for (int ti = 0; ti < 4; ++ti) acc[ti] = __builtin_amdgcn_mfma_f32_16x16x4f32(av[ks], bv[ti][ks], acc[ti], 0, 0, 0);
#pragma unroll
            for (int ti = 0; ti < 4; ++ti)
#pragma unroll
                for (int r = 0; r < 4; ++r) yb[(size_t)(tt * 16 + r) * RW + ti * 16] = acc[ti][r];
        }
    }
}

__device__ __forceinline__ void phase_finalize(const Params& p, const Lt& lt, int l) {
    const int tid = lt.tid, lane = tid & 63, w = tid >> 6;
    const float* yraw = (const float*)(p.ws + WS_YRAW); const float* oraw = (const float*)(p.ws + WS_ORAW); const unsigned char* opnd = p.ws + WS_OPND;
    const float* gate = (const float*)(p.ws + WS_GATE); const float* bonus = (const float*)(p.ws + WS_BONUS); const float* ssqa = (const float*)(p.ws + WS_SSQA);
    const float* lg = p.in[12] + l * RW; const float* lb = p.in[13] + l * RW; const float* ang = p.in[15] + l * RW;
    bf16_t* mix = (bf16_t*)(p.ws + WS_MIX);
    for (int t = lt.bid * 8 + w; t < SEQ; t += gridDim.x * 8) {
        const f32x4 sq = *(const f32x4*)(ssqa + (size_t)t * 4);
        const float ra = rsqrtf((sq[0] + sq[1] + sq[2] + sq[3]) * (1.0f / RW) + NORM_EPS);
#pragma unroll
        for (int rnd = 0; rnd < 3; ++rnd) {
            const int c = rnd * 256 + lane * 4, h = c >> 6, cc = c & 63;
            const f32x4 y = *(const f32x4*)(yraw + (size_t)t * RW + c);
            const float m = row16_sum(y[0] + y[1] + y[2] + y[3]) * (1.0f / 64);
            const f32x4 d = y - m;
            const float var = row16_sum(d[0] * d[0] + d[1] * d[1] + d[2] * d[2] + d[3] * d[3]) * (1.0f / 64);
            const float rs = rsqrtf(var + GN_EPS);
            const f32x4 g4 = *(const f32x4*)(lg + c), b4 = *(const f32x4*)(lb + c), v4 = ld_bf4((const bf16_t*)(opnd + (size_t)t * OPTB + h * OPB + 640 + cc * 2)), gt = ld_bf4((const bf16_t*)gate + (size_t)t * RW + c);
            const float bo = bonus[(size_t)t * 16 + h];
            const f32x4 o = (d * rs * g4 + b4 + v4 * bo) * gt;
            u32x2 pk; pk.x = cvt_pk_bf16(o[0], o[1]); pk.y = cvt_pk_bf16(o[2], o[3]);
            *(u32x2*)(mix + (size_t)t * DM + c) = pk;
            const f32x4 oa = *(const f32x4*)(oraw + (size_t)t * RW + c) * ra * *(const f32x4*)(ang + c);
            u32x2 pa; pa.x = cvt_pk_bf16(oa[0], oa[1]); pa.y = cvt_pk_bf16(oa[2], oa[3]);
            *(u32x2*)(mix + (size_t)t * DM + RW + c) = pa;
        }
    }
}

__device__ __forceinline__ void phase_final_norm(const Params& p, const Lt& lt) {
    const int tid = lt.tid, lane = tid & 63, w = tid >> 6;
    const float* x = (const float*)(p.ws + WS_X); const float* ssq = (const float*)(p.ws + WS_SSQ); const float* g = p.in[25];
    for (int t = lt.bid * 8 + w; t < SEQ; t += gridDim.x * 8) {
        const float rs = row_rstd(ssq, t, 1.0f / DM);
#pragma unroll
        for (int i = 0; i < 8; ++i) {
            const int c = i * 256 + lane * 4;
            *(f32x4*)(p.out + (size_t)t * DM + c) = *(const f32x4*)(x + (size_t)t * DM + c) * rs * *(const f32x4*)(g + c);
        }
    }
}

#define XB_TMO      128
#define XB_XCNT(j)  (256  + 64 * (j))
#define XB_XSUB(j)  (1280 + 64 * (j))
#define XB_XGEN(j)  (2304 + 64 * (j))
#define XB_TOP      3328
#define XB_TOPGEN   3392
#define XCD_BAR_WORDS 3456
#define XB_SPIN_CAP (1u << 22)
__device__ __forceinline__ unsigned xb_ld(unsigned* p)              { return __hip_atomic_load(p, __ATOMIC_RELAXED, __HIP_MEMORY_SCOPE_AGENT); }
__device__ __forceinline__ unsigned xb_add(unsigned* p, unsigned v) { return __hip_atomic_fetch_add(p, v, __ATOMIC_RELAXED, __HIP_MEMORY_SCOPE_AGENT); }
__device__ __forceinline__ unsigned xb_xcc_id() { return (unsigned)__builtin_amdgcn_s_getreg((3 << 11) | 20) & 0xFu; }
#define XB_SPIN(cond, bar) do { unsigned _sp = 0; while (cond) { __builtin_amdgcn_s_sleep(1); \
    if ((++_sp & 255u) == 0u) { if (xb_ld(&(bar)[XB_TMO])) break; if (_sp > XB_SPIN_CAP) { atomicAdd(&(bar)[XB_TMO], 1u); break; } } } } while (0)
struct XcdBarrier { unsigned* bar; unsigned x; volatile LAS unsigned* st; };
__device__ __forceinline__ XcdBarrier xcd_barrier_post(unsigned* bar, volatile LAS unsigned* st) {
    XcdBarrier b; b.bar = bar; b.x = xb_xcc_id(); b.st = st;
    if (threadIdx.x == 0) (void)xb_add(&bar[XB_XCNT(b.x)], 1u);
    return b;
}
__device__ __forceinline__ void xcd_barrier_complete(unsigned* bar, unsigned x, unsigned& nloc, unsigned& nx) {
    const unsigned G = gridDim.x * gridDim.y * gridDim.z;
    unsigned sum, cnt, mine, sp = 0u;
    for (;;) {
        sum = 0u; cnt = 0u; mine = 0u;
#pragma unroll
        for (unsigned j = 0; j < 16; ++j) { const unsigned c = xb_ld(&bar[XB_XCNT(j)]); sum += c; cnt += (c > 0u) ? 1u : 0u; mine = (j == x) ? c : mine; }
        if (sum == G) break;
        __builtin_amdgcn_s_sleep(1);
        if ((++sp & 255u) == 0u) { if (xb_ld(&bar[XB_TMO])) break; if (sp > XB_SPIN_CAP) { atomicAdd(&bar[XB_TMO], 1u); break; } }
    }
    nloc = mine > 0u ? mine : 1u; nx = cnt > 0u ? cnt : 1u;
}
__device__ __forceinline__ void xcd_barrier(const XcdBarrier& b) {
    asm volatile("s_waitcnt vmcnt(0)" ::: "memory");
    __syncthreads();
    if (threadIdx.x == 0) {
        unsigned* bar = b.bar;
        __builtin_amdgcn_s_waitcnt(0);
        unsigned nloc = b.st[0], nx = b.st[1];
        if (nloc == 0u) { xcd_barrier_complete(bar, b.x, nloc, nx); b.st[0] = nloc; b.st[1] = nx; }
        const unsigned old = xb_add(&bar[XB_XSUB(b.x)], 1u);
        const unsigned gen = old / nloc;
        if (old + 1u == (gen + 1u) * nloc) {
            __builtin_amdgcn_fence(__ATOMIC_RELEASE, "agent");
            asm volatile("s_waitcnt vmcnt(0)" ::: "memory");
            const unsigned og = xb_add(&bar[XB_TOP], 1u);
            const unsigned tg = og / nx;
            if (og + 1u == (tg + 1u) * nx) xb_add(&bar[XB_TOPGEN], 1u);
            else XB_SPIN(xb_ld(&bar[XB_TOPGEN]) == tg, bar);
            __builtin_amdgcn_fence(__ATOMIC_ACQUIRE, "agent");
            xb_add(&bar[XB_XGEN(b.x)], 1u);
            asm volatile("s_waitcnt vmcnt(0)" ::: "memory");
        } else {
            XB_SPIN(xb_ld(&bar[XB_XGEN(b.x)]) == gen, bar);
            __builtin_amdgcn_fence(__ATOMIC_ACQUIRE, "agent");
            asm volatile("s_waitcnt vmcnt(0)" ::: "memory");
        }
    }
    __syncthreads();
}

constexpr int NPHASE = 2 + 9 * DEPTH;
template <bool COOP>
__global__ void __launch_bounds__(NTHREADS, 2) mega(Params p0) {
    extern __shared__ __attribute__((aligned(16))) unsigned char lds[];
    const int G = gridDim.x;
    XcdBarrier xbar; xbar.bar = nullptr; xbar.x = 0; xbar.st = nullptr;
    if (COOP) {
        volatile LAS unsigned* st = (volatile LAS unsigned*)((LAS unsigned char*)lds + (LDS_BYTES - 16));
        if (threadIdx.x < 4) st[threadIdx.x] = 0u;
        __syncthreads();
        xbar = xcd_barrier_post((unsigned*)(p0.ws + WS_BAR), st);
    }
    for (int ph0 = p0.ph_lo * 2; ph0 < p0.ph_hi * 2; ++ph0) {
        const int ph = ph0 >> 1;
        const int kind = (ph == 0) ? 9 : (ph == NPHASE - 1 ? 10 : (ph - 1) % 9);
        const bool rep = ((MK_REP_MASK >> kind) & 1) != 0;
        if ((ph0 & 1) && !rep) continue;
        Params p = p0; Lt lt; lt.tid = threadIdx.x; lt.bid = blockIdx.x;
        asm volatile("" : "+v"(lt.tid)); asm volatile("" : "+s"(lt.bid));
        { size_t z = 0; asm volatile("" : "+s"(z)); p.ws = p0.ws + z; }
        unsigned char* ws = p.ws;
        if (ph == 0) { if (SEL(0)) phase_prep(p, lt, lds); }
        else if (ph == NPHASE - 1) { if (SEL(1)) phase_final_norm(p, lt); }
        else {
            const int l = (ph - 1) / 9, k = (ph - 1) % 9;
            if (k == 0) { if (SEL(2)) {
                pg8::Gemm g{(const bf16_t*)(ws + WS_XB), (const bf16_t*)(ws + WS_WIN + l * SZ_WIN), SEQ, INC, DM}; pg8::StaticOrder S; S.init(SEQ, INC, G, lt.bid);
                EpiScaleBf16<0> E{(bf16_t*)(ws + WS_P), INC, (const float*)(ws + WS_SSQ)};
                pg8::gemm_phase(lt, (LAS unsigned char*)lds, g, S, E);
                if (G == 256 && lt.bid >= 96 && !(ph0 & 1)) { __syncthreads(); convert_layer(p, lt, l, 864, CONV_TILES, lt.bid - 96, 160, (float*)lds); } }
            } else if (k == 1) {
#pragma unroll 1
                for (int it = lt.bid; it < 256; it += G) {
                    Lt li = lt; asm volatile("" : "+v"(li.tid));
                    if (SEL(4)) rwkv_prep_item(p, li, l, G == 256 ? 2 * (it & 127) + (it >> 7) : it);
                }
            } else if (k == 2) { if (SEL(6)) phase_scan1(p, lt, lds); }
            else if (k == 3) {
                const int nsc = (G >= 192) ? 48 : G;
                if (lt.bid < nsc) { if (SEL(7)) phase_scan2(p, lt, nsc, lds); }
                const int nat = (G >= 192) ? G - 48 : G, b0 = (G >= 192) ? lt.bid - 48 : lt.bid;
                if (b0 >= 0) {
                    if (nat >= 128) {
                        Lt li = lt; asm volatile("" : "+v"(li.tid));
                        if (b0 < 64) { if (SEL(5)) gmlp_item(p, li, l, b0, lds); }
                        else {
#pragma unroll 1
                            for (int it = b0 - 64; it < 256; it += nat - 64) { Lt lj = lt; asm volatile("" : "+v"(lj.tid)); if (SEL(3)) attn_item(p, lj, l, it, lds); }
                        }
                    } else {
#pragma unroll 1
                        for (int it = b0; it < 320; it += nat) {
                            Lt li = lt; asm volatile("" : "+v"(li.tid));
                            if (it < 64) { if (SEL(5)) gmlp_item(p, li, l, it, lds); }
                            else { if (SEL(3)) attn_item(p, li, l, it - 64, lds); }
                        }
                    }
                    if (G == 256 && l + 1 < DEPTH && !(ph0 & 1) && b0 >= 64) convert_layer(p, lt, l + 1, 0, 864, b0 - 64, nat - 64, (float*)lds);
                }
            }
            else if (k == 4) { if (SEL(8)) phase_scan3(p, lt, lds); }
            else if (k == 5) { if (SEL(9)) phase_finalize(p, lt, l); }
            else if (k == 6) { if (SEL(10)) {
                pg8::Gemm g{(const bf16_t*)(ws + WS_MIX), (const bf16_t*)(ws + WS_WOUT + l * SZ_WOUT), SEQ, DM, DM}; pg8::StaticOrder S; S.init(SEQ, DM, G, lt.bid);
                EpiRes E{l == 0 ? p.in[0] : (const float*)(ws + WS_X), (float*)(ws + WS_X), (bf16_t*)(ws + WS_XB), (float*)(ws + WS_SSQ)};
                pg8::gemm_phase(lt, (LAS unsigned char*)lds, g, S, E); }
            } else if (k == 7) { if (SEL(11)) {
                pg8::Gemm g{(const bf16_t*)(ws + WS_XB), (const bf16_t*)(ws + WS_WUP + l * SZ_WUP), SEQ, DFF, DM}; pg8::StaticOrder S; S.init(SEQ, DFF, G, lt.bid);
                EpiScaleBf16<1> E{(bf16_t*)(ws + WS_HB), DFF, (const float*)(ws + WS_SSQ)};
                pg8::gemm_phase(lt, (LAS unsigned char*)lds, g, S, E); }
            } else { if (SEL(12)) {
                pg8::Gemm g{(const bf16_t*)(ws + WS_HB), (const bf16_t*)(ws + WS_WDN + l * SZ_WDN), SEQ, DM, DFF}; pg8::StaticOrder S; S.init(SEQ, DM, G, lt.bid);
                EpiRes E{(const float*)(ws + WS_X), (float*)(ws + WS_X), (bf16_t*)(ws + WS_XB), (float*)(ws + WS_SSQ)};
                pg8::gemm_phase(lt, (LAS unsigned char*)lds, g, S, E); }
            }
        }
        if (COOP) { const bool lastexec = (ph + 1 == p0.ph_hi) && ((ph0 & 1) || !rep); if (!lastexec) { if (p0.ph_hi > NPHASE) cg::this_grid().sync(); else xcd_barrier(xbar); } }
    }
}

extern "C" void kernel_launch(void* const* d_in, const int* in_sizes, int n_in, void* d_out, int out_size, void* d_ws, size_t ws_size, hipStream_t stream) {
    static int grid = 0;
    if (grid == 0) {
        if (n_in != 26 || ws_size < WS_END) { fprintf(stderr, "kernel_launch: unexpected inputs (%d) or workspace (%zu < %zu)\n", n_in, ws_size, (size_t)WS_END); grid = -1; return; }
        int dev = 0, cus = 0, per_cu = 0;
        hipGetDevice(&dev);
        hipDeviceGetAttribute(&cus, hipDeviceAttributeMultiprocessorCount, dev);
        hipFuncSetAttribute((const void*)mega<MK_COOP != 0>, hipFuncAttributeMaxDynamicSharedMemorySize, LDS_BYTES);
        hipOccupancyMaxActiveBlocksPerMultiprocessor(&per_cu, (const void*)mega<MK_COOP != 0>, NTHREADS, LDS_BYTES);
        per_cu = 1;
        grid = cus * per_cu;
        (void)hipGetLastError();
    }
    if (grid < 0) return;
    Params p{};
    for (int i = 0; i < 26; ++i) p.in[i] = (const float*)d_in[i];
    p.out = (float*)d_out; p.ws = (unsigned char*)d_ws;
#if MK_COOP
    p.ph_lo = 0; p.ph_hi = NPHASE;
    (void)hipMemsetAsync((unsigned char*)d_ws + WS_BAR, 0, 16384, stream);
    void* args[] = {&p};
    hipError_t e = hipLaunchCooperativeKernel((const void*)mega<true>, dim3(grid), dim3(NTHREADS), args, LDS_BYTES, stream);
    if (e != hipSuccess) fprintf(stderr, "cooperative launch failed: %s (grid %d)\n", hipGetErrorString(e), grid);
#else
    for (int ph = 0; ph < NPHASE; ++ph) {
        p.ph_lo = ph; p.ph_hi = ph + 1;
        hipLaunchKernelGGL(mega<false>, dim3(grid), dim3(NTHREADS), LDS_BYTES, stream, p);
    }
#endif
}
```
